# Optimizing an MI355X kernel written in HIP

```python
import functools
import jax, jax.numpy as jnp
from jax import lax
import numpy as np

D_MODEL = 1024
BATCH = 8
SEQ = 2048
DEPTH = 2
DEC_BATCH = 128
DEC_SEQ = 8
PAST_LEN = 16384
PAGE_SIZE = 128

N_POOL_LAYERS = (DEPTH + 1) // 2
N_GDN_LAYERS = DEPTH // 2

POOL_WINDOWS = (2, 4, 8, 16)
N_POOL_GROUPS = len(POOL_WINDOWS)
POOL_GROUP_DIM = D_MODEL // N_POOL_GROUPS
POOL_BUF = max(POOL_WINDOWS) - 1

GDN_K_HEADS = 8
GDN_V_HEADS = 16
GDN_HEAD_K = 128
GDN_HEAD_V = 128
GDN_QK_DIM = GDN_K_HEADS * GDN_HEAD_K
GDN_V_DIM = GDN_V_HEADS * GDN_HEAD_V
GDN_CONV_DIM = 2 * GDN_QK_DIM + GDN_V_DIM
GDN_IN_DIM = GDN_CONV_DIM + GDN_V_DIM + 2 * GDN_V_HEADS
CONV_WIDTH = 4
CHUNK = 64

D_FF = -(-8 * D_MODEL // (3 * 256)) * 256

EPS = 1e-6

kernel_name = 'hybrid_pool_gdn_decoder_step'


def rms_norm(x, gain):
    xf = x.astype(jnp.float32)
    y = xf * lax.rsqrt(jnp.mean(xf * xf, axis=-1, keepdims=True) + EPS)
    return (y * gain.astype(jnp.float32)).astype(x.dtype)


def l2norm(x):
    xf = x.astype(jnp.float32)
    return xf * lax.rsqrt(jnp.sum(xf * xf, axis=-1, keepdims=True) + EPS)


def swiglu(h, w_in, w_out):
    gu = h @ w_in
    return (jax.nn.silu(gu[..., :D_FF]) * gu[..., D_FF:]) @ w_out


def pool_mixer(h, buf, w_grp, scale, n_past):
    B, L, _ = h.shape
    hp = jnp.concatenate([buf.astype(h.dtype), h], axis=1)
    hf = hp.astype(jnp.float32)
    cs = jnp.cumsum(hf, axis=1)
    cs = jnp.concatenate([jnp.zeros_like(cs[:, :1]), cs], axis=1)
    cur = hf[:, POOL_BUF:]
    t = jnp.arange(L)
    diffs = []
    for gi, win in enumerate(POOL_WINDOWS):
        c0, c1 = gi * POOL_GROUP_DIM, (gi + 1) * POOL_GROUP_DIM
        total = (cs[:, POOL_BUF + 1:POOL_BUF + 1 + L, c0:c1]
                 - cs[:, POOL_BUF + 1 - win:POOL_BUF + 1 - win + L, c0:c1])
        count = jnp.minimum(win, t + 1 + n_past).astype(jnp.float32)[None, :, None]
        diffs.append(total / count - cur[..., c0:c1])
    d = jnp.stack(diffs, axis=2)
    y = jnp.einsum('blgc,gce->blge', d, w_grp.astype(jnp.float32)).reshape(B, L, D_MODEL)
    y = y * scale.astype(jnp.float32)
    return y.astype(h.dtype), hp[:, L:]


def short_conv(u, buf, w):
    L = u.shape[1]
    up = jnp.concatenate([buf.astype(u.dtype), u], axis=1)
    out = up[:, 0:L] * w[0]
    for tap in range(1, CONV_WIDTH):
        out = out + up[:, tap:tap + L] * w[tap]
    return jax.nn.silu(out), up[:, L:]


def gated_delta_chunked(q, k, v, g, beta, s0):
    B, L, H, _ = q.shape
    n = -(-L // CHUNK)
    pad = n * CHUNK - L

    def blocks(x):
        x = jnp.pad(x, [(0, 0), (0, pad)] + [(0, 0)] * (x.ndim - 2))
        x = x.reshape((B, n, CHUNK) + x.shape[2:])
        return jnp.moveaxis(x, 3, 1)

    q, k, v, g, beta = blocks(q), blocks(k), blocks(v), blocks(g), blocks(beta)
    gc = jnp.cumsum(g, axis=-1)
    idx = jnp.arange(CHUNK)
    causal = idx[:, None] >= idx[None, :]
    strict = idx[:, None] > idx[None, :]
    decay = jnp.exp(jnp.where(causal, gc[..., :, None] - gc[..., None, :], -jnp.inf))
    kb = k * beta[..., None]
    a_mat = jnp.where(strict, jnp.einsum('bhnid,bhnjd->bhnij', kb, k) * decay, 0.0)
    t_mat = a_mat + jnp.eye(CHUNK, dtype=jnp.float32)
    solve = functools.partial(lax.linalg.triangular_solve, left_side=True, lower=True,
                              unit_diagonal=True)
    u = solve(t_mat, v * beta[..., None])
    w = solve(t_mat, kb * jnp.exp(gc)[..., None])
    qk = jnp.einsum('bhnid,bhnjd->bhnij', q, k) * decay
    q_dec = q * jnp.exp(gc)[..., None]
    k_dec = k * jnp.exp(gc[..., -1:] - gc)[..., None]
    g_last = jnp.exp(gc[..., -1])
    xs = tuple(jnp.moveaxis(a, 2, 0) for a in (u, w, qk, q_dec, k_dec, g_last))

    def step(S, inp):
        u_i, w_i, qk_i, qd_i, kd_i, gl_i = inp
        v_new = u_i - jnp.einsum('bhck,bhkv->bhcv', w_i, S)
        o_i = jnp.einsum('bhck,bhkv->bhcv', qd_i, S) + jnp.einsum('bhcs,bhsv->bhcv', qk_i, v_new)
        S = S * gl_i[..., None, None] + jnp.einsum('bhck,bhcv->bhkv', kd_i, v_new)
        return S, o_i

    s_fin, o = lax.scan(step, s0, xs)
    o = jnp.transpose(o, (1, 0, 3, 2, 4)).reshape(B, n * CHUNK, H, o.shape[-1])[:, :L]
    return o, s_fin


def gdn_mixer(h, conv_buf, s0, w_in, conv_w, a_log, dt_bias, o_norm, w_out):
    B, L, _ = h.shape
    proj = h @ w_in
    qkv = proj[..., :GDN_CONV_DIM]
    z = proj[..., GDN_CONV_DIM:GDN_CONV_DIM + GDN_V_DIM]
    b = proj[..., GDN_CONV_DIM + GDN_V_DIM:GDN_CONV_DIM + GDN_V_DIM + GDN_V_HEADS]
    a = proj[..., GDN_CONV_DIM + GDN_V_DIM + GDN_V_HEADS:]
    qkv_c, new_conv = short_conv(qkv, conv_buf, conv_w)
    rep = GDN_V_HEADS // GDN_K_HEADS
    q = l2norm(qkv_c[..., :GDN_QK_DIM].reshape(B, L, GDN_K_HEADS, GDN_HEAD_K)) * (GDN_HEAD_K ** -0.5)
    k = l2norm(qkv_c[..., GDN_QK_DIM:2 * GDN_QK_DIM].reshape(B, L, GDN_K_HEADS, GDN_HEAD_K))
    q = jnp.repeat(q, rep, axis=2)
    k = jnp.repeat(k, rep, axis=2)
    v = qkv_c[..., 2 * GDN_QK_DIM:].reshape(B, L, GDN_V_HEADS, GDN_HEAD_V).astype(jnp.float32)
    beta = jax.nn.sigmoid(b.astype(jnp.float32))
    g = -jnp.exp(a_log.astype(jnp.float32)) * jax.nn.softplus(a.astype(jnp.float32) + dt_bias.astype(jnp.float32))
    o, s_new = gated_delta_chunked(q, k, v, g, beta, s0.astype(jnp.float32))
    zf = z.reshape(B, L, GDN_V_HEADS, GDN_HEAD_V).astype(jnp.float32)
    o = rms_norm(o, o_norm) * jax.nn.silu(zf)
    y = o.reshape(B, L, GDN_V_DIM).astype(h.dtype) @ w_out
    return y, new_conv, s_new.astype(s0.dtype)


def trunk(x, pool_bufs, conv_bufs, rec_states, n_past_pool, norm_mix_pre, norm_mix_post,
          norm_ffn_pre, norm_ffn_post, pool_w, pool_scale, gdn_w_in, gdn_conv_w, gdn_a_log,
          gdn_dt_bias, gdn_o_norm, gdn_w_out, ffn_w_in, ffn_w_out):
    new_pool, new_conv, new_rec = [], [], []
    for i in range(DEPTH):
        j = i // 2
        h = rms_norm(x, norm_mix_pre[i])
        if i % 2 == 0:
            m, nb = pool_mixer(h, pool_bufs[j], pool_w[j], pool_scale[j], n_past_pool)
            new_pool.append(nb)
        else:
            m, nc, ns = gdn_mixer(h, conv_bufs[j], rec_states[j], gdn_w_in[j], gdn_conv_w[j],
                                  gdn_a_log[j], gdn_dt_bias[j], gdn_o_norm[j], gdn_w_out[j])
            new_conv.append(nc)
            new_rec.append(ns)
        x = x + rms_norm(m, norm_mix_post[i])
        h = rms_norm(x, norm_ffn_pre[i])
        x = x + rms_norm(swiglu(h, ffn_w_in[i], ffn_w_out[i]), norm_ffn_post[i])
    return x, jnp.stack(new_pool), jnp.stack(new_conv), jnp.stack(new_rec)


def setup_inputs(seed: int = 0) -> dict:
    key = jax.random.key(seed)
    ks = jax.random.split(key, 20)
    f32 = jnp.float32
    nrm = lambda k, s: jax.random.normal(k, s, f32)
    dt = jnp.exp(jax.random.uniform(ks[13], (N_GDN_LAYERS, GDN_V_HEADS), f32,
                                    jnp.log(0.001), jnp.log(0.1)))
    return {
        'x_prompt': nrm(ks[0], (BATCH, SEQ, D_MODEL)),
        'x_sample': nrm(ks[1], (DEC_BATCH, DEC_SEQ, D_MODEL)),
        'state_pool': nrm(ks[2], (N_POOL_LAYERS, DEC_BATCH, POOL_BUF, D_MODEL)),
        'state_gdn_conv': nrm(ks[3], (N_GDN_LAYERS, DEC_BATCH, CONV_WIDTH - 1, GDN_CONV_DIM)),
        'state_gdn_rec': 0.1 * nrm(ks[4], (N_GDN_LAYERS, DEC_BATCH, GDN_V_HEADS, GDN_HEAD_K, GDN_HEAD_V)),
        'norm_mix_pre': 1.0 + 0.05 * nrm(ks[5], (DEPTH, D_MODEL)),
        'norm_mix_post': 1.0 + 0.05 * nrm(ks[6], (DEPTH, D_MODEL)),
        'norm_ffn_pre': 1.0 + 0.05 * nrm(ks[7], (DEPTH, D_MODEL)),
        'norm_ffn_post': 1.0 + 0.05 * nrm(ks[8], (DEPTH, D_MODEL)),
        'pool_w': nrm(ks[9], (N_POOL_LAYERS, N_POOL_GROUPS, POOL_GROUP_DIM, POOL_GROUP_DIM)) * POOL_GROUP_DIM ** -0.5,
        'pool_scale': 1.0 + 0.1 * nrm(ks[10], (N_POOL_LAYERS, D_MODEL)),
        'gdn_w_in': nrm(ks[11], (N_GDN_LAYERS, D_MODEL, GDN_IN_DIM)) * D_MODEL ** -0.5,
        'gdn_conv_w': nrm(ks[12], (N_GDN_LAYERS, CONV_WIDTH, GDN_CONV_DIM)) * CONV_WIDTH ** -0.5,
        'gdn_a_log': jnp.log(jax.random.uniform(ks[14], (N_GDN_LAYERS, GDN_V_HEADS), f32, 1.0, 16.0)),
        'gdn_dt_bias': dt + jnp.log(-jnp.expm1(-dt)),
        'gdn_o_norm': 1.0 + 0.05 * nrm(ks[15], (N_GDN_LAYERS, GDN_HEAD_V)),
        'gdn_w_out': nrm(ks[16], (N_GDN_LAYERS, GDN_V_DIM, D_MODEL)) * GDN_V_DIM ** -0.5,
        'ffn_w_in': nrm(ks[17], (DEPTH, D_MODEL, 2 * D_FF)) * D_MODEL ** -0.5,
        'ffn_w_out': nrm(ks[18], (DEPTH, D_FF, D_MODEL)) * D_FF ** -0.5,
    }


def reference(x_prompt, x_sample, state_pool, state_gdn_conv, state_gdn_rec, norm_mix_pre,
              norm_mix_post, norm_ffn_pre, norm_ffn_post, pool_w, pool_scale, gdn_w_in,
              gdn_conv_w, gdn_a_log, gdn_dt_bias, gdn_o_norm, gdn_w_out, ffn_w_in, ffn_w_out):
    bp = x_prompt.shape[0]
    zero_pool = jnp.zeros((N_POOL_LAYERS, bp, POOL_BUF, D_MODEL), x_prompt.dtype)
    zero_conv = jnp.zeros((N_GDN_LAYERS, bp, CONV_WIDTH - 1, GDN_CONV_DIM), x_prompt.dtype)
    zero_rec = jnp.zeros((N_GDN_LAYERS, bp, GDN_V_HEADS, GDN_HEAD_K, GDN_HEAD_V), state_gdn_rec.dtype)
    y_prompt, pool_p, conv_p, rec_p = trunk(
        x_prompt, zero_pool, zero_conv, zero_rec, 0, norm_mix_pre, norm_mix_post, norm_ffn_pre,
        norm_ffn_post, pool_w, pool_scale, gdn_w_in, gdn_conv_w, gdn_a_log, gdn_dt_bias,
        gdn_o_norm, gdn_w_out, ffn_w_in, ffn_w_out)
    y_sample, pool_s, conv_s, rec_s = trunk(
        x_sample, state_pool, state_gdn_conv, state_gdn_rec, min(PAST_LEN, POOL_BUF), norm_mix_pre,
        norm_mix_post, norm_ffn_pre, norm_ffn_post, pool_w, pool_scale, gdn_w_in, gdn_conv_w,
        gdn_a_log, gdn_dt_bias, gdn_o_norm, gdn_w_out, ffn_w_in, ffn_w_out)
    return (y_prompt, y_sample, pool_p, pool_s, conv_p, conv_s, rec_p, rec_s)
```

```cpp
#include <hip/hip_runtime.h>
#include <hip/hip_cooperative_groups.h>
#include <cstdio>
namespace cg = cooperative_groups;

#define LAS __attribute__((address_space(3)))
typedef unsigned short bf16_t;
typedef short bf16x8 __attribute__((ext_vector_type(8)));
typedef float f32x4 __attribute__((ext_vector_type(4)));
typedef float f32x2 __attribute__((ext_vector_type(2)));
typedef unsigned u32x4 __attribute__((ext_vector_type(4)));
typedef unsigned u32x2 __attribute__((ext_vector_type(2)));

constexpr int D = 1024, TP = 16384, TS = 1024, T = TP + TS, SEQ = 2048;
constexpr int DFF = 2816, NFI = 5632, NGI = 6176, NGIP = 6400;
constexpr float EPS = 1e-6f;
constexpr int LDS_BYTES = 147456;
constexpr int NPHASE = 15;
#ifndef ONLY
#define ONLY -1
#endif
#define PHON(n) (ONLY < 0 || ONLY == (n))

constexpr size_t SZ_TD2 = (size_t)T * 1024 * 2;
constexpr size_t OFF_WP = 0;
constexpr size_t OFF_WFI = OFF_WP + 524288;
constexpr size_t OFF_WFO = OFF_WFI + 23068672;
constexpr size_t OFF_WGI = OFF_WFO + 11534336;
constexpr size_t OFF_WGO = OFF_WGI + 13107200;
constexpr size_t OFF_DB = OFF_WGO + 4194304;
constexpr size_t OFF_H = OFF_DB + SZ_TD2;
constexpr size_t OFF_ON = OFF_DB;
constexpr size_t OFF_MR = OFF_H + SZ_TD2;
constexpr size_t OFF_QB = OFF_MR, OFF_KB = OFF_MR + SZ_TD2;
constexpr size_t OFF_BIG = OFF_MR + 2 * SZ_TD2;
constexpr size_t OFF_Z = OFF_BIG + 142606336;
constexpr size_t OFF_BA = OFF_Z + 71303168;
constexpr size_t OFF_VB = OFF_BA + 8912896;
constexpr size_t OFF_GC = OFF_VB + 71303168;
constexpr size_t OFF_BETA = OFF_GC + 1572864;
constexpr size_t OFF_BAR = OFF_BETA + 1572864;
constexpr size_t OFF_XB = OFF_BAR + 16384;
constexpr size_t WS_END = OFF_XB + SZ_TD2;

constexpr size_t O_Y = 0;
constexpr size_t O_POOLP = (size_t)T * 1024;
constexpr size_t O_POOLS = O_POOLP + 8 * 15 * 1024;
constexpr size_t O_CONVP = O_POOLS + 128 * 15 * 1024;
constexpr size_t O_CONVS = O_CONVP + 8 * 3 * 4096;
constexpr size_t O_RECP = O_CONVS + 128 * 3 * 4096;
constexpr size_t O_RECS = O_RECP + (size_t)8 * 16 * 128 * 128;

struct Args { const float* in[19]; float* out; unsigned char* ws; int ph_lo, ph_hi; };

typedef __bf16 bf16x2_t __attribute__((ext_vector_type(2)));
__device__ __forceinline__ unsigned pk2(float lo, float hi) { const f32x2 v = {lo, hi}; const bf16x2_t r = __builtin_convertvector(v, bf16x2_t); return __builtin_bit_cast(unsigned, r); }
__device__ __forceinline__ float bf2f(bf16_t b) { return __uint_as_float(((unsigned)b) << 16); }
__device__ __forceinline__ float bflo(unsigned w) { return __uint_as_float(w << 16); }
__device__ __forceinline__ float bfhi(unsigned w) { return __uint_as_float(w & 0xffff0000u); }
__device__ __forceinline__ float silu_f(float x) { return x * __builtin_amdgcn_rcpf(1.0f + __expf(-x)); }
__device__ __forceinline__ float wave_sum(float v) {
#pragma unroll
    for (int o = 1; o < 64; o <<= 1) v += __shfl_xor(v, o);
    return v;
}
#define LDS_WAIT() asm volatile("s_waitcnt lgkmcnt(0)" ::: "memory")
#define LBAR() do { asm volatile("s_waitcnt lgkmcnt(0)" ::: "memory"); __builtin_amdgcn_s_barrier(); asm volatile("" ::: "memory"); } while (0)

#define XB_TMO      128
#define XB_XCNT(j)  (256  + 64 * (j))
#define XB_XSUB(j)  (1280 + 64 * (j))
#define XB_XGEN(j)  (2304 + 64 * (j))
#define XB_TOP      3328
#define XB_TOPGEN   3392
#define XCD_BAR_WORDS 3456
#define XB_SPIN_CAP (1u << 18)
__device__ __forceinline__ unsigned xb_ld(unsigned* p)              { return __hip_atomic_load(p, __ATOMIC_RELAXED, __HIP_MEMORY_SCOPE_AGENT); }
__device__ __forceinline__ unsigned xb_add(unsigned* p, unsigned v) { return __hip_atomic_fetch_add(p, v, __ATOMIC_RELAXED, __HIP_MEMORY_SCOPE_AGENT); }
__device__ __forceinline__ unsigned xb_xcc_id() { return (unsigned)__builtin_amdgcn_s_getreg((3 << 11) | 20) & 0xFu; }
#define XB_SPIN(cond, bar) do { unsigned _sp = 0; while (cond) { __builtin_amdgcn_s_sleep(1); \
    if ((++_sp & 255u) == 0u) { if (xb_ld(&(bar)[XB_TMO])) break; if (_sp > XB_SPIN_CAP) { atomicAdd(&(bar)[XB_TMO], 1u); break; } } } } while (0)
__device__ __forceinline__ void xcd_barrier_complete(unsigned* bar, unsigned x, unsigned& nloc, unsigned& nx) {
    const unsigned G = gridDim.x * gridDim.y * gridDim.z;
    unsigned sum, cnt, mine, sp = 0u;
    for (;;) {
        sum = 0u; cnt = 0u; mine = 0u;
#pragma unroll
        for (unsigned j = 0; j < 16; ++j) { const unsigned c = xb_ld(&bar[XB_XCNT(j)]); sum += c; cnt += (c > 0u) ? 1u : 0u; mine = (j == x) ? c : mine; }
        if (sum == G) break;
        __builtin_amdgcn_s_sleep(1);
        if ((++sp & 255u) == 0u) { if (xb_ld(&bar[XB_TMO])) break; if (sp > XB_SPIN_CAP) { atomicAdd(&bar[XB_TMO], 1u); break; } }
    }
    nloc = mine > 0u ? mine : 1u; nx = cnt > 0u ? cnt : 1u;
}
__device__ __forceinline__ void xcd_barrier(unsigned* bar, volatile LAS unsigned* st) {
    asm volatile("s_waitcnt vmcnt(0)" ::: "memory");
    __syncthreads();
    if (threadIdx.x == 0) {
        const unsigned x = xb_xcc_id();
        __builtin_amdgcn_s_waitcnt(0);
        unsigned nloc = st[0], nx = st[1];
        if (nloc == 0u) { xcd_barrier_complete(bar, x, nloc, nx); st[0] = nloc; st[1] = nx; }
        const unsigned old = xb_add(&bar[XB_XSUB(x)], 1u);
        const unsigned gen = old / nloc;
        if (old + 1u == (gen + 1u) * nloc) {
            __builtin_amdgcn_fence(__ATOMIC_RELEASE, "agent");
            asm volatile("s_waitcnt vmcnt(0)" ::: "memory");
            const unsigned og = xb_add(&bar[XB_TOP], 1u);
            const unsigned tg = og / nx;
            if (og + 1u == (tg + 1u) * nx) xb_add(&bar[XB_TOPGEN], 1u);
            else XB_SPIN(xb_ld(&bar[XB_TOPGEN]) == tg, bar);
            __builtin_amdgcn_fence(__ATOMIC_ACQUIRE, "agent");
            xb_add(&bar[XB_XGEN(x)], 1u);
            asm volatile("s_waitcnt vmcnt(0)" ::: "memory");
        } else {
            XB_SPIN(xb_ld(&bar[XB_XGEN(x)]) == gen, bar);
            __builtin_amdgcn_fence(__ATOMIC_ACQUIRE, "agent");
            asm volatile("s_waitcnt vmcnt(0)" ::: "memory");
        }
    }
    __syncthreads();
}

namespace pg8 {
constexpr int BM = 256, BK = 64, HALF = 128, HTB = HALF * BK * 2, NXCD = 8, WGM = 8;
__device__ __forceinline__ int lds_byte(int r, int c) { const int st = (r >> 4) * 2 + (c >> 5), rr = r & 15, cc = c & 31, ob = rr * 64 + cc * 2; return st * 1024 + (ob ^ (((ob >> 9) & 1) << 5)); }
__device__ __forceinline__ void stage_rc(int b, int& R, int& C) { const int st = b / 1024, sb = b % 1024, swz = sb ^ (((sb >> 9) & 1) << 5); R = (st >> 1) * 16 + swz / 64; C = (st & 1) * 32 + (swz % 64) / 2; }
__device__ __forceinline__ int perm32(int rho) { const int n = rho >> 4, i = rho & 15; return 8 * (i >> 2) + 4 * n + (i & 3); }
struct Unit { int pm, pn, k0, nt, part; };
template <int LDA, int LDB, int APN> struct Gemm { const bf16_t* A; const bf16_t* Bt; static constexpr int lda = LDA, ldb = LDB, a_pn_off = APN; };
template <int nM, int nN, int ntK, int nMs, int nsplit>
struct StaticOrder {
    static constexpr int nwg = nM * nN, ntS = nsplit ? ntK / (nsplit ? nsplit : 1) : 0;
    int G, c;
    __device__ void init(int G_, int c_) { G = G_; c = c_; }
    __device__ __forceinline__ bool next(int i, Unit& u) const {
        const int L = i * G + c;
        const bool full = L < nwg;
        const int L2r = L - ((nwg + G - 1) / G) * G;
        const bool split = !full && nMs > 0 && L2r >= 0 && L2r < nMs * nN * nsplit;
        if (!full && !split) return false;
        const int L2 = split ? L2r : 0;
        int wgid = full ? L : 0; { constexpr int q = nwg / NXCD, r = nwg % NXCD; const int xcd = wgid % NXCD, off = wgid / NXCD; wgid = (xcd < r ? xcd * (q + 1) : r * (q + 1) + (xcd - r) * q) + off; }
        constexpr int nig = WGM * nN; const int gid = wgid / nig, fm = gid * WGM, gsz = (nM - fm) < WGM ? (nM - fm) : WGM;
        const int pm_f = fm + ((wgid % nig) % gsz), pn_f = (wgid % nig) / gsz;
        constexpr int nMs1 = nMs ? nMs : 1;
        const int part = L2 / (nN * nMs1);
        const int pm = full ? pm_f : nM + (L2 / nN) % nMs1, pn = full ? pn_f : L2 % nN, k0 = full ? 0 : part * ntS * 64, nt = full ? ntK : ntS, pt = full ? -1 : part;
        u.pm = pm; u.pn = pn; u.k0 = k0; u.nt = nt; u.part = pt;
        return true;
    }
};

struct EpiF32Scale {
    static constexpr bool PERM = false;
    float* C; int ldc; float* P; int prow0;
    __device__ __forceinline__ void operator()(const f32x4 (&acc)[2][2][4][2], const Unit& u, int wr, int wc, int fr, int fq) const {
        const int col0 = u.pn * BM + wc * 32 + 4 * fq;
        int row0 = u.pm * BM + wr * 64 + fr; float* C = this->C;
        if (u.part >= 0) { row0 -= prow0; C = P + (size_t)u.part * 1024 * 1024; }
#pragma unroll
        for (int ai = 0; ai < 2; ++ai)
#pragma unroll
            for (int m = 0; m < 4; ++m) { float* rowp = C + (size_t)(row0 + ai * HALF + m * 16) * ldc + col0;
#pragma unroll
                for (int bj = 0; bj < 2; ++bj)
#pragma unroll
                    for (int n = 0; n < 2; ++n) {
                        if (u.part >= 0) *(f32x4*)(rowp + bj * HALF + n * 16) = acc[ai][bj][m][n];
                        else { const f32x4 v = acc[ai][bj][m][n]; u32x2 wv; wv.x = pk2(v[0], v[1]); wv.y = pk2(v[2], v[3]);
                               *(u32x2*)((bf16_t*)this->C + (size_t)(row0 + ai * HALF + m * 16) * ldc + col0 + bj * HALF + n * 16) = wv; } } }
    }
};
struct EpiSwiGLU {
    static constexpr bool PERM = true;
    bf16_t* O;
    __device__ __forceinline__ void operator()(const f32x4 (&acc)[2][2][4][2], const Unit& u, int wr, int wc, int fr, int fq) const {
        const int row0 = u.pm * BM + wr * 64 + fr, col0 = u.pn * 128 + wc * 32 + 8 * fq;
#pragma unroll
        for (int ai = 0; ai < 2; ++ai)
#pragma unroll
            for (int m = 0; m < 4; ++m) { bf16_t* rowp = O + (size_t)(row0 + ai * HALF + m * 16) * DFF + col0;
                const f32x4 g0 = acc[ai][0][m][0], g1 = acc[ai][0][m][1], u0 = acc[ai][1][m][0], u1 = acc[ai][1][m][1];
                u32x4 w;
                w.x = pk2(silu_f(g0[0]) * u0[0], silu_f(g0[1]) * u0[1]); w.y = pk2(silu_f(g0[2]) * u0[2], silu_f(g0[3]) * u0[3]);
                w.z = pk2(silu_f(g1[0]) * u1[0], silu_f(g1[1]) * u1[1]); w.w = pk2(silu_f(g1[2]) * u1[2], silu_f(g1[3]) * u1[3]);
                *(u32x4*)rowp = w; }
    }
};
struct EpiProj {
    static constexpr bool PERM = true;
    bf16_t *PQKV, *Z, *BA;
    __device__ __forceinline__ void operator()(const f32x4 (&acc)[2][2][4][2], const Unit& u, int wr, int wc, int fr, int fq) const {
        bf16_t* base; int ld;
        if (u.pn < 16) { base = PQKV + u.pn * 256; ld = 4096; } else if (u.pn < 24) { base = Z + (u.pn - 16) * 256; ld = 2048; } else { base = BA; ld = 256; }
        const int row0 = u.pm * BM + wr * 64 + fr, col0 = wc * 32 + 8 * fq;
#pragma unroll
        for (int ai = 0; ai < 2; ++ai)
#pragma unroll
            for (int m = 0; m < 4; ++m) { bf16_t* rowp = base + (size_t)(row0 + ai * HALF + m * 16) * ld + col0;
#pragma unroll
                for (int bj = 0; bj < 2; ++bj) { const f32x4 v0 = acc[ai][bj][m][0], v1 = acc[ai][bj][m][1];
                    u32x4 w; w.x = pk2(v0[0], v0[1]); w.y = pk2(v0[2], v0[3]); w.z = pk2(v1[0], v1[1]); w.w = pk2(v1[2], v1[3]);
                    *(u32x4*)(rowp + bj * HALF) = w; } }
    }
};

template <class Epi, class GemmT, class Sched>
__device__ __forceinline__ void gemm_phase(LAS unsigned char* lds, const GemmT g, const Sched& S, const Epi& E, const int tid) {
    const int wid = __builtin_amdgcn_readfirstlane(tid >> 6), lane = tid & 63, wr = wid >> 2, wc = wid & 3, fr = lane & 15, fq = lane >> 4;
    unsigned voffA[2], voffB[2];
#pragma unroll
    for (int i = 0; i < 2; ++i) { int R, C; stage_rc(tid * 16 + i * 8192, R, C); const int Rb = Epi::PERM ? ((R & ~31) + perm32(R & 31)) : R;
        voffA[i] = (unsigned)(R * g.lda + C) * 2u; voffB[i] = (unsigned)(Rb * g.ldb + C) * 2u; }
    const size_t kstep = (size_t)(BK * 2);
    const size_t hstepA = (size_t)HALF * g.lda * 2, hstepB = (size_t)HALF * g.ldb * 2;
    const unsigned ldsw = (unsigned)wid * 1024u;
    const int aoff = lds_byte(wr * 64 + fr, fq * 8), boff = lds_byte(wc * 32 + fr, fq * 8);
#define PG8_SA(b, h) (((b) * 2 + (h)) * HTB)
#define PG8_SB(b, h) ((4 + (b) * 2 + (h)) * HTB)
#define PG8_STAGE(bufoff, gbase, voff) do { _Pragma("unroll") for (int _i = 0; _i < 2; ++_i) \
        __builtin_amdgcn_global_load_lds((const unsigned*)((const char*)(gbase) + (voff)[_i]), (LAS unsigned*)(lds + (bufoff) + ldsw + _i * 8192), 16, 0, 0); } while (0)
#define PG8_LDA(dst, b, h) do { _Pragma("unroll") for (int m = 0; m < 4; ++m) _Pragma("unroll") for (int k = 0; k < 2; ++k) dst[m][k] = *(const LAS bf16x8*)(lds + PG8_SA(b, h) + aoff + m * 2048 + k * 1024); } while (0)
#define PG8_LDB(dst, b, h) do { _Pragma("unroll") for (int n = 0; n < 2; ++n) _Pragma("unroll") for (int k = 0; k < 2; ++k) dst[n][k] = *(const LAS bf16x8*)(lds + PG8_SB(b, h) + boff + n * 2048 + k * 1024); } while (0)
#define PG8_MMA(ai, bj, At, Bt) do { __builtin_amdgcn_s_setprio(1); _Pragma("unroll") for (int m = 0; m < 4; ++m) _Pragma("unroll") for (int n = 0; n < 2; ++n) _Pragma("unroll") for (int k = 0; k < 2; ++k) \
        acc[ai][bj][m][n] = __builtin_amdgcn_mfma_f32_16x16x32_bf16(Bt[n][k], At[m][k], acc[ai][bj][m][n], 0, 0, 0); __builtin_amdgcn_s_setprio(0); } while (0)
#define PG8_WAIT_V(n) asm volatile("s_waitcnt vmcnt(" #n ")" ::: "memory")
#define PG8_WAIT_L(n) asm volatile("s_waitcnt lgkmcnt(" #n ")" ::: "memory")
#define PG8_BAR __builtin_amdgcn_s_barrier()
#define PG8_SCHED __builtin_amdgcn_sched_barrier(0)
    Unit cur, nxt; int ui = 0;
    if (!S.next(0, cur)) return;
    f32x4 acc[2][2][4][2];
#pragma unroll
    for (int a = 0; a < 2; ++a)
#pragma unroll
        for (int b = 0; b < 2; ++b)
#pragma unroll
            for (int m = 0; m < 4; ++m)
#pragma unroll
                for (int n = 0; n < 2; ++n) acc[a][b][m][n] = (f32x4){0.f, 0.f, 0.f, 0.f};
    bf16x8 At[4][2], B0[2][2], B1[2][2];
    const char* cA = (const char*)g.A + (size_t)cur.pm * 2 * hstepA + (size_t)(cur.pn * g.a_pn_off + cur.k0) * 2; const char* cB = (const char*)g.Bt + (size_t)cur.pn * 2 * hstepB + (size_t)cur.k0 * 2;
    PG8_STAGE(PG8_SB(0, 0), cB, voffB); PG8_STAGE(PG8_SA(0, 0), cA, voffA); PG8_STAGE(PG8_SB(0, 1), cB + hstepB, voffB); PG8_STAGE(PG8_SA(0, 1), cA + hstepA, voffA);
    if (wr == 1) PG8_BAR;
    PG8_WAIT_V(4); PG8_BAR;
    PG8_STAGE(PG8_SB(1, 0), cB + kstep, voffB); PG8_STAGE(PG8_SA(1, 0), cA + kstep, voffA); PG8_STAGE(PG8_SB(1, 1), cB + hstepB + kstep, voffB);
    PG8_WAIT_V(6); PG8_BAR;
    for (;;) {
        const bool has_next = S.next(ui + 1, nxt);
        const char* nA = has_next ? (const char*)g.A + (size_t)nxt.pm * 2 * hstepA + (size_t)(nxt.pn * g.a_pn_off + nxt.k0) * 2 : cA; const char* nB = has_next ? (const char*)g.Bt + (size_t)nxt.pn * 2 * hstepB + (size_t)nxt.k0 * 2 : cB;
        const int nt = cur.nt;
        for (int t = 0; t < nt; t += 2) {
            const bool last = (t == nt - 2);
            const char* a1 = cA + (size_t)(t + 1) * kstep;
            const char* a2 = last ? nA : cA + (size_t)(t + 2) * kstep; const char* b2 = last ? nB : cB + (size_t)(t + 2) * kstep;
            const char* a3 = a2 + kstep; const char* b3 = b2 + kstep;
            PG8_LDB(B0, 0, 0); PG8_SCHED; PG8_LDA(At, 0, 0); PG8_STAGE(PG8_SA(1, 1), a1 + hstepA, voffA);
            PG8_WAIT_L(8); PG8_BAR; PG8_WAIT_L(0); PG8_MMA(0, 0, At, B0); PG8_BAR; PG8_SCHED;
            PG8_LDB(B1, 0, 1); PG8_STAGE(PG8_SB(0, 0), b2, voffB);
            PG8_BAR; PG8_WAIT_L(0); PG8_MMA(0, 1, At, B1); PG8_BAR;
            PG8_LDA(At, 0, 1); PG8_STAGE(PG8_SA(0, 0), a2, voffA);
            PG8_BAR; PG8_WAIT_L(0); PG8_MMA(1, 0, At, B0); PG8_BAR; PG8_SCHED;
            PG8_STAGE(PG8_SB(0, 1), b2 + hstepB, voffB);
            PG8_WAIT_V(6); PG8_BAR; PG8_MMA(1, 1, At, B1); PG8_BAR;
            PG8_LDB(B0, 1, 0); PG8_SCHED; PG8_LDA(At, 1, 0); PG8_STAGE(PG8_SA(0, 1), a2 + hstepA, voffA);
            PG8_WAIT_L(8); PG8_BAR; PG8_WAIT_L(0); PG8_MMA(0, 0, At, B0); PG8_BAR; PG8_SCHED;
            PG8_LDB(B1, 1, 1); PG8_STAGE(PG8_SB(1, 0), b3, voffB);
            PG8_BAR; PG8_WAIT_L(0); PG8_MMA(0, 1, At, B1); PG8_BAR;
            PG8_LDA(At, 1, 1); PG8_STAGE(PG8_SA(1, 0), a3, voffA);
            PG8_BAR; PG8_WAIT_L(0); PG8_MMA(1, 0, At, B0); PG8_BAR; PG8_SCHED;
            PG8_STAGE(PG8_SB(1, 1), b3 + hstepB, voffB);
            PG8_WAIT_V(6); PG8_BAR; PG8_MMA(1, 1, At, B1); PG8_BAR;
        }
        E(acc, cur, wr, wc, fr, fq);
        if (!has_next) break;
#pragma unroll
        for (int a = 0; a < 2; ++a)
#pragma unroll
            for (int b = 0; b < 2; ++b)
#pragma unroll
                for (int m = 0; m < 4; ++m)
#pragma unroll
                    for (int n = 0; n < 2; ++n) acc[a][b][m][n] = (f32x4){0.f, 0.f, 0.f, 0.f};
        cur = nxt; cA = nA; cB = nB; ++ui;
    }
    PG8_WAIT_V(0);
    if (wr == 0) PG8_BAR;
    PG8_BAR;
#undef PG8_SA
#undef PG8_SB
#undef PG8_STAGE
#undef PG8_LDA
#undef PG8_LDB
#undef PG8_MMA
#undef PG8_WAIT_V
#undef PG8_WAIT_L
#undef PG8_BAR
#undef PG8_SCHED
}
}

struct Frame {
    LAS unsigned char* lds;
    int tid, lane, wave, gw, NGW, G, blk;
    const float* in[19];
    float* out; unsigned char* ws;
};
#define WSP(type, off) ((type*)(F.ws + (off)))

__device__ __forceinline__ void transpose_item(const float* W, int N, int k0, int nsrc0, bf16_t* WT, int K, int ndst0, LAS float* scr, int lane) {
    float wv[32];
#pragma unroll
    for (int i = 0; i < 32; ++i) wv[i] = __builtin_nontemporal_load(W + (size_t)(k0 + 2 * i + (lane >> 5)) * N + nsrc0 + (lane & 31));
#pragma unroll
    for (int i = 0; i < 32; ++i) scr[(2 * i + (lane >> 5)) * 33 + (lane & 31)] = wv[i];
    LDS_WAIT();
    const int c = lane & 7;
#pragma unroll
    for (int j = 0; j < 4; ++j) { const int n = (lane >> 3) + 8 * j; const LAS float* s = scr + (8 * c) * 33 + n;
        u32x4 o; o.x = pk2(s[0 * 33], s[1 * 33]); o.y = pk2(s[2 * 33], s[3 * 33]); o.z = pk2(s[4 * 33], s[5 * 33]); o.w = pk2(s[6 * 33], s[7 * 33]);
        *(u32x4*)(WT + (size_t)(ndst0 + n) * K + k0 + 8 * c) = o; }
    LDS_WAIT();
}

__device__ __forceinline__ void front_phase(Frame& F) {
    LAS float* rs = (LAS float*)(F.lds + 8 * 8448);
    const float* xp = F.in[0]; const float* xs = F.in[1]; const float* spool = F.in[2]; const float* gain = F.in[5];
    bf16_t* DB = WSP(bf16_t, OFF_DB);
    const int tid = F.tid, c = 2 * tid, gi = tid >> 7, win = 2 << gi;
    const f32x2 gn = *(const f32x2*)(gain + c);
    const float inv_win = 1.0f / (float)win;
    for (int item = F.blk; item < 512 + 128; item += F.G) {
        __syncthreads();
        if (item < 512) {
            const int b = item >> 6, l0 = (item & 63) * 32;
            const float* xb = xp + (size_t)b * SEQ * D;
            { float sq[6];
#pragma unroll
              for (int i = 0; i < 6; ++i) { const int r = F.wave + 8 * i, l = l0 - 15 + r; const bool ok = r < 47 && l >= 0;
                  const f32x4* xr = (const f32x4*)(xb + (size_t)(ok ? l : l0) * D) + F.lane; float s = 0.f;
#pragma unroll
                  for (int j = 0; j < 4; ++j) { const f32x4 q = xr[64 * j]; s += q.x * q.x + q.y * q.y + q.z * q.z + q.w * q.w; }
                  sq[i] = ok ? s : 0.f; }
#pragma unroll
              for (int i = 0; i < 6; ++i) { const int r = F.wave + 8 * i; const float v = rsqrtf(wave_sum(sq[i]) * (1.0f / D) + EPS);
                  if (F.lane == 0 && r < 47) rs[r] = v; } }
            __syncthreads();
            f32x2 S = {0.f, 0.f};
#pragma unroll
            for (int d = 1; d < 16; ++d) { const int j = l0 - d; const bool ok = d < win && j >= 0;
                const f32x2 xv = *(const f32x2*)(xb + (size_t)(ok ? j : l0) * D + c); const float r = ok ? rs[15 - d] : 0.f; S.x += xv.x * r * gn.x; S.y += xv.y * r * gn.y; }
#pragma unroll 16
            for (int l = l0; l < l0 + 32; ++l) {
                const f32x2 xv = *(const f32x2*)(xb + (size_t)l * D + c); const float r = rs[l - l0 + 15];
                const f32x2 hv = {xv.x * r * gn.x, xv.y * r * gn.y};
                S.x += hv.x; S.y += hv.y;
                const float ic = (l + 1 < win) ? 1.0f / (float)(l + 1) : inv_win;
                *(unsigned*)(DB + (size_t)(b * SEQ + l) * D + c) = pk2(S.x * ic - hv.x, S.y * ic - hv.y);
                const int jo = l - win + 1;
                if (jo >= 0) { const f32x2 xo = *(const f32x2*)(xb + (size_t)jo * D + c); const float ro = rs[jo - l0 + 15]; S.x -= xo.x * ro * gn.x; S.y -= xo.y * ro * gn.y; }
                if (l >= SEQ - 15) *(f32x2*)(F.out + O_POOLP + (size_t)(b * 15 + (l - (SEQ - 15))) * D + c) = hv;
            }
        } else {
            const int s0 = item - 512;
            { const int r = F.wave; const f32x4* xr = (const f32x4*)(xs + (size_t)(s0 * 8 + r) * D) + F.lane; float s = 0.f;
#pragma unroll
                for (int j = 0; j < 4; ++j) { const f32x4 q = xr[64 * j]; s += q.x * q.x + q.y * q.y + q.z * q.z + q.w * q.w; }
                const float v = rsqrtf(wave_sum(s) * (1.0f / D) + EPS);
                if (F.lane == 0) rs[r] = v; }
            __syncthreads();
            { const int si = 0;
                const int s = s0 + si; const float* buf = spool + (size_t)s * 15 * D; const float* xq = xs + (size_t)s * 8 * D;
                float* po = F.out + O_POOLS + (size_t)s * 15 * D;
                f32x2 S = {0.f, 0.f};
#pragma unroll
                for (int d = 1; d < 16; ++d) { const bool ok = d < win; const f32x2 bv = *(const f32x2*)(buf + (size_t)(ok ? 15 - d : 14) * D + c); if (ok) { S.x += bv.x; S.y += bv.y; } }
                for (int i = 0; i < 7; ++i) *(f32x2*)(po + (size_t)i * D + c) = *(const f32x2*)(buf + (size_t)(8 + i) * D + c);
#pragma unroll
                for (int l = 0; l < 8; ++l) {
                    const f32x2 xv = *(const f32x2*)(xq + (size_t)l * D + c); const float r = rs[si * 8 + l];
                    const f32x2 hv = {xv.x * r * gn.x, xv.y * r * gn.y};
                    S.x += hv.x; S.y += hv.y;
                    *(unsigned*)(DB + (size_t)(TP + s * 8 + l) * D + c) = pk2(S.x * inv_win - hv.x, S.y * inv_win - hv.y);
                    const int jo = l - win + 1;
                    if (jo >= 0) { const f32x2 xo = *(const f32x2*)(xq + (size_t)jo * D + c); const float ro = rs[si * 8 + jo]; S.x -= xo.x * ro * gn.x; S.y -= xo.y * ro * gn.y; }
                    else { const f32x2 bv = *(const f32x2*)(buf + (size_t)(jo + 15) * D + c); S.x -= bv.x; S.y -= bv.y; }
                    *(f32x2*)(po + (size_t)(7 + l) * D + c) = hv;
                }
            }
        }
    }
}

__device__ __forceinline__ void transpose_items(Frame& F, bool late, int gw0, int ngw) {
    LAS float* scr = (LAS float*)(F.lds + F.wave * 8448);
    constexpr int I_P = 4 * 4 * 8, I_FI = 16 * 176, I_FO = 44 * 32, I_GI = 16 * 193, I_GO = 32 * 32;
    const int nitems = late ? I_FI + I_FO + I_GO : I_P + I_FI + I_FO + I_GI;
    const int ly = late ? 1 : 0;
    for (int it = gw0; it < nitems; it += ngw) {
        int r = it;
        if (!late) {
            if (r < I_P) { const int g = r >> 5, q = r & 31, kb = q >> 3, nb = q & 7;
                transpose_item(F.in[9] + (size_t)g * 65536, 256, 64 * kb, 32 * nb, WSP(bf16_t, OFF_WP), 256, g * 256 + 32 * nb, scr, F.lane); continue; }
            r -= I_P;
        }
        if (r < I_FI) { const int kb = r / 176, nb = r % 176;
            const int nd = 32 * nb, pn = nd >> 8, rr = nd & 255, ns = rr < 128 ? 128 * pn + rr : DFF + 128 * pn + (rr - 128);
            transpose_item(F.in[17] + (size_t)ly * 1024 * NFI, NFI, 64 * kb, ns, WSP(bf16_t, OFF_WFI) + (size_t)ly * NFI * 1024, 1024, nd, scr, F.lane); continue; }
        r -= I_FI;
        if (r < I_FO) { const int kb = r >> 5, nb = r & 31;
            transpose_item(F.in[18] + (size_t)ly * DFF * 1024, 1024, 64 * kb, 32 * nb, WSP(bf16_t, OFF_WFO) + (size_t)ly * 1024 * DFF, DFF, 32 * nb, scr, F.lane); continue; }
        r -= I_FO;
        if (!late) { const int kb = r / 193, nb = r % 193;
            transpose_item(F.in[11], NGI, 64 * kb, 32 * nb, WSP(bf16_t, OFF_WGI), 1024, 32 * nb, scr, F.lane); }
        else { const int kb = r >> 5, nb = r & 31;
            transpose_item(F.in[16], 1024, 64 * kb, 32 * nb, WSP(bf16_t, OFF_WGO), 2048, 32 * nb, scr, F.lane); }
    }
}
__device__ __forceinline__ void prep_phase(Frame& F) {
    transpose_items(F, false, F.gw, F.NGW);
    { u32x4* z = (u32x4*)(WSP(bf16_t, OFF_WGI) + (size_t)NGI * 1024); const int n16 = (NGIP - NGI) * 1024 * 2 / 16;
      unsigned z0 = 0u; asm volatile("" : "+v"(z0));
      for (int i = F.blk * 512 + F.tid; i < n16; i += F.G * 512) z[i] = (u32x4){z0, z0, z0, z0}; }
    front_phase(F);
}

struct RowRaw { u32x2 m[4]; u32x2 xb[4]; f32x4 xf[4]; };
template <int nparts>
__device__ __forceinline__ void row_phase(Frame& F, const float* xin_p, const float* xin_s, const float* gpost, const float* gpre, const float* mscale, bool out_f32) {
    const bf16_t* MRb = WSP(bf16_t, OFF_MR); bf16_t* H = WSP(bf16_t, OFF_H); float* XA = F.out + O_Y; bf16_t* XB = WSP(bf16_t, OFF_XB);
    f32x4 gp[4], gq[4];
#pragma unroll
    for (int j = 0; j < 4; ++j) { gp[j] = ((const f32x4*)gpost)[F.lane + 64 * j]; gq[j] = gpre ? ((const f32x4*)gpre)[F.lane + 64 * j] : (f32x4){0.f, 0.f, 0.f, 0.f}; }
    auto issue = [&](int row, RowRaw& r) {
        const bool part = nparts > 0 && row >= TP;
        if (!part) {
#pragma unroll
            for (int j = 0; j < 4; ++j) r.m[j] = __builtin_nontemporal_load((const u32x2*)(MRb + (size_t)row * D) + F.lane + 64 * j); }
        if (xin_p) { const f32x4* xr = (const f32x4*)(row < TP ? xin_p + (size_t)row * D : xin_s + (size_t)(row - TP) * D) + F.lane;
#pragma unroll
            for (int j = 0; j < 4; ++j) r.xf[j] = __builtin_nontemporal_load(xr + 64 * j); }
        else {
#pragma unroll
            for (int j = 0; j < 4; ++j) r.xb[j] = __builtin_nontemporal_load((const u32x2*)(XB + (size_t)row * D) + F.lane + 64 * j); }
    };
    RowRaw cur, nxt;
    int row = F.gw;
    if (row < T) issue(row, cur);
    for (; row < T; row += F.NGW) {
        const int rn = row + F.NGW;
        if (rn < T) issue(rn, nxt);
        f32x4 m[4], x[4]; float s = 0.f;
#pragma unroll
        for (int j = 0; j < 4; ++j) {
            if (nparts > 0 && row >= TP) { const f32x4* pr = (const f32x4*)(WSP(float, OFF_Z) + (size_t)(row - TP) * D) + F.lane + 64 * j;
                f32x4 pv[nparts > 0 ? nparts : 1];
#pragma unroll
                for (int p = 0; p < nparts; ++p) pv[p] = pr[(size_t)p * (1024 * 1024 / 4)];
                f32x4 a = pv[0];
#pragma unroll
                for (int p = 1; p < nparts; ++p) a = a + pv[p];
                m[j] = a; }
            else m[j] = (f32x4){bflo(cur.m[j].x), bfhi(cur.m[j].x), bflo(cur.m[j].y), bfhi(cur.m[j].y)};
            if (mscale) m[j] = m[j] * ((const f32x4*)mscale)[F.lane + 64 * j];
            if (xin_p) x[j] = cur.xf[j]; else x[j] = (f32x4){bflo(cur.xb[j].x), bfhi(cur.xb[j].x), bflo(cur.xb[j].y), bfhi(cur.xb[j].y)};
            s += m[j].x * m[j].x + m[j].y * m[j].y + m[j].z * m[j].z + m[j].w * m[j].w; }
        const float r1 = rsqrtf(wave_sum(s) * (1.0f / D) + EPS); float s2 = 0.f;
#pragma unroll
        for (int j = 0; j < 4; ++j) { x[j] = x[j] + m[j] * r1 * gp[j]; s2 += x[j].x * x[j].x + x[j].y * x[j].y + x[j].z * x[j].z + x[j].w * x[j].w; }
        if (out_f32) { f32x4* xo = (f32x4*)(XA + (size_t)row * D) + F.lane;
#pragma unroll
            for (int j = 0; j < 4; ++j) __builtin_nontemporal_store(x[j], xo + 64 * j); }
        else { u32x2* xo = (u32x2*)(XB + (size_t)row * D) + F.lane;
#pragma unroll
            for (int j = 0; j < 4; ++j) { u32x2 w; w.x = pk2(x[j].x, x[j].y); w.y = pk2(x[j].z, x[j].w); xo[64 * j] = w; } }
        if (gpre) {
            const float r2 = rsqrtf(wave_sum(s2) * (1.0f / D) + EPS);
            u32x2* ho = (u32x2*)(H + (size_t)row * D) + F.lane;
#pragma unroll
            for (int j = 0; j < 4; ++j) { const f32x4 h = x[j] * r2 * gq[j]; u32x2 w; w.x = pk2(h.x, h.y); w.y = pk2(h.z, h.w); ho[64 * j] = w; }
        }
        cur = nxt;
    }
}

template <int NROWS>
__device__ __forceinline__ void conv_rows(const u32x4 (&rawv)[16], int t0, f32x4 (&u)[3][2], const f32x4 (&w)[4][2], int slab, int ch0, bf16_t* dst, int dld, float* cout, int l_first_out) {
#pragma unroll
    for (int i = 0; i < NROWS; ++i) {
        const u32x4 raw = rawv[i];
        f32x4 c0 = {bflo(raw.x), bfhi(raw.x), bflo(raw.y), bfhi(raw.y)}, c1 = {bflo(raw.z), bfhi(raw.z), bflo(raw.w), bfhi(raw.w)};
        f32x4 o0 = w[0][0] * u[2][0] + w[1][0] * u[1][0] + w[2][0] * u[0][0] + w[3][0] * c0;
        f32x4 o1 = w[0][1] * u[2][1] + w[1][1] * u[1][1] + w[2][1] * u[0][1] + w[3][1] * c1;
#pragma unroll
        for (int e = 0; e < 4; ++e) { o0[e] = silu_f(o0[e]); o1[e] = silu_f(o1[e]); }
        if (slab < 4) {
            float ss = o0.x * o0.x + o0.y * o0.y + o0.z * o0.z + o0.w * o0.w + o1.x * o1.x + o1.y * o1.y + o1.z * o1.z + o1.w * o1.w;
            ss += __shfl_xor(ss, 1); ss += __shfl_xor(ss, 2); ss += __shfl_xor(ss, 4); ss += __shfl_xor(ss, 8);
            float sc = rsqrtf(ss + EPS); if (slab < 2) sc *= 0.08838834764831845f;
            o0 = o0 * sc; o1 = o1 * sc;
        }
        u32x4 pk; pk.x = pk2(o0.x, o0.y); pk.y = pk2(o0.z, o0.w); pk.z = pk2(o1.x, o1.y); pk.w = pk2(o1.z, o1.w);
        *(u32x4*)(dst + (size_t)(t0 + i) * dld) = pk;
        if (cout && i >= l_first_out) { float* co = cout + (size_t)(i - l_first_out) * 4096; *(f32x4*)co = c0; *(f32x4*)(co + 4) = c1; }
        u[2][0] = u[1][0]; u[2][1] = u[1][1]; u[1][0] = u[0][0]; u[1][1] = u[0][1]; u[0][0] = c0; u[0][1] = c1;
    }
}
__device__ __forceinline__ void conv_phase(Frame& F) {
    const bf16_t* PQKV = WSP(bf16_t, OFF_BIG); const float* cw = F.in[12]; const float* cst = F.in[3];
    constexpr int NI = (1024 + 128) * 8;
    auto loadrows = [&](int it_, u32x4 (&rv)[16]) {
        const int rt_ = it_ >> 3, c_ = (it_ & 7) * 512 + F.lane * 8;
        const int t_ = rt_ < 1024 ? (rt_ >> 7) * SEQ + (rt_ & 127) * 16 : TP + (rt_ - 1024) * 8, nr_ = rt_ < 1024 ? 16 : 8;
#pragma unroll
        for (int i = 0; i < 16; ++i) rv[i] = __builtin_nontemporal_load((const u32x4*)(PQKV + (size_t)(t_ + (i < nr_ ? i : 0)) * 4096 + c_));
    };
    u32x4 rc[16], rn[16];
    if (F.gw < NI) loadrows(F.gw, rc);
    for (int item = F.gw; item < NI; item += F.NGW) {
        if (item + F.NGW < NI) loadrows(item + F.NGW, rn);
        const int rt = item >> 3, slab = item & 7, ch0 = slab * 512 + F.lane * 8;
        f32x4 w[4][2];
#pragma unroll
        for (int tp = 0; tp < 4; ++tp) { w[tp][0] = *(const f32x4*)(cw + tp * 4096 + ch0); w[tp][1] = *(const f32x4*)(cw + tp * 4096 + ch0 + 4); }
        bf16_t* dst; int dld;
        if (slab < 2) { dst = WSP(bf16_t, OFF_QB) + ch0; dld = 1024; } else if (slab < 4) { dst = WSP(bf16_t, OFF_KB) + (ch0 - 1024); dld = 1024; } else { dst = WSP(bf16_t, OFF_VB) + (ch0 - 2048); dld = 2048; }
        f32x4 u[3][2];
        if (rt < 1024) {
            const int b = rt >> 7, l0 = (rt & 127) * 16, t0 = b * SEQ + l0;
#pragma unroll
            for (int p = 0; p < 3; ++p) {
                if (l0 > 0) { const u32x4 raw = *(const u32x4*)(PQKV + (size_t)(t0 - 1 - p) * 4096 + ch0);
                    u[p][0] = (f32x4){bflo(raw.x), bfhi(raw.x), bflo(raw.y), bfhi(raw.y)}; u[p][1] = (f32x4){bflo(raw.z), bfhi(raw.z), bflo(raw.w), bfhi(raw.w)}; }
                else { u[p][0] = (f32x4){0.f, 0.f, 0.f, 0.f}; u[p][1] = (f32x4){0.f, 0.f, 0.f, 0.f}; } }
            const bool tail = (l0 == SEQ - 16);
            conv_rows<16>(rc, t0, u, w, slab, ch0, dst, dld, tail ? F.out + O_CONVP + (size_t)b * 3 * 4096 + ch0 : nullptr, 13);
        } else {
            {
                const int s = rt - 1024, t0 = TP + s * 8;
#pragma unroll
                for (int p = 0; p < 3; ++p) { const float* sp = cst + (size_t)(s * 3 + (2 - p)) * 4096 + ch0; u[p][0] = *(const f32x4*)sp; u[p][1] = *(const f32x4*)(sp + 4); }
                conv_rows<8>(rc, t0, u, w, slab, ch0, dst, dld, F.out + O_CONVS + (size_t)s * 3 * 4096 + ch0, 5);
            }
        }
#pragma unroll
        for (int i = 0; i < 16; ++i) rc[i] = rn[i];
    }
}

template <int I> __device__ __forceinline__ void fs_row(float (&X)[64], const LAS float* Am, bf16_t* tinv, int lane, int nvalid, int nst) {
    float a = (lane == I) ? 1.f : 0.f;
    if (I < nvalid) {
        float a1 = 0.f, a2 = 0.f, a3 = 0.f, a4 = 0.f, a5 = 0.f, a6 = 0.f, a7 = 0.f;
#pragma unroll
        for (int j4 = 0; j4 < (I + 3) / 4; ++j4) { const f32x4 av = *(const LAS f32x4*)(Am + I * 68 + 4 * j4);
            if (j4 & 1) {
                if (4 * j4 + 0 < I) a4 -= av[0] * X[4 * j4 + 0];
                if (4 * j4 + 1 < I) a5 -= av[1] * X[4 * j4 + 1];
                if (4 * j4 + 2 < I) a6 -= av[2] * X[4 * j4 + 2];
                if (4 * j4 + 3 < I) a7 -= av[3] * X[4 * j4 + 3];
            } else {
                if (4 * j4 + 0 < I) a -= av[0] * X[4 * j4 + 0];
                if (4 * j4 + 1 < I) a1 -= av[1] * X[4 * j4 + 1];
                if (4 * j4 + 2 < I) a2 -= av[2] * X[4 * j4 + 2];
                if (4 * j4 + 3 < I) a3 -= av[3] * X[4 * j4 + 3];
            } }
        a = ((a + a1) + (a2 + a3)) + ((a4 + a5) + (a6 + a7));
    }
    X[I] = a;
    if (I < nst) tinv[I * 64 + lane] = (bf16_t)(pk2(a, 0.f) & 0xffffu);
    asm volatile("" ::: "memory");
}
__device__ __forceinline__ void gdn_pre_phase(Frame& F) {
    LAS float* Am = (LAS float*)(F.lds + F.wave * 17920);
    LAS float* gcs = Am + 64 * 68; LAS float* bts = gcs + 64;
    const bf16_t* QB = WSP(bf16_t, OFF_QB); const bf16_t* KB = WSP(bf16_t, OFF_KB); const bf16_t* BA = WSP(bf16_t, OFF_BA);
    bf16_t* TQ = WSP(bf16_t, OFF_BIG); float* GC = WSP(float, OFF_GC); float* BETA = WSP(float, OFF_BETA);
    for (int it = F.gw; it < 6144; it += F.NGW) {
        int lane = F.lane; asm volatile("" : "+v"(lane));
        const int c16 = lane & 15, q = lane >> 4;
        int t0, nvalid; const int h = it & 15, kh = h >> 1;
        if (it < 4096) { const int b = it >> 9, n = (it >> 4) & 31; t0 = b * SEQ + n * 64; nvalid = 64; } else { const int s = (it - 4096) >> 4; t0 = TP + s * 8; nvalid = 8; }
        const int nti = nvalid > 16 ? 4 : 1, nst = nvalid > 16 ? 64 : 16;
        float beta = 0.f, g = 0.f;
        { const int lr = lane < nvalid ? lane : 0;
            const float bb = bf2f(BA[(size_t)(t0 + lr) * 256 + h]), aa = bf2f(BA[(size_t)(t0 + lr) * 256 + 16 + h]);
            const float xx = aa + F.in[14][h]; const float sp = xx > 20.f ? xx : log1pf(__expf(xx));
            if (lane < nvalid) { beta = 1.0f / (1.0f + __expf(-bb)); g = -__expf(F.in[13][h]) * sp; }
        }
        float gc = g;
#pragma unroll
        for (int o = 1; o < 64; o <<= 1) { const float tv = __shfl_up(gc, o); if (lane >= o) gc += tv; }
        GC[(size_t)it * 64 + lane] = gc; BETA[(size_t)it * 64 + lane] = beta; gcs[lane] = gc; bts[lane] = beta;
        f32x4 kka[10], qka[10];
#pragma unroll
        for (int x = 0; x < 10; ++x) { kka[x] = (f32x4){0.f, 0.f, 0.f, 0.f}; qka[x] = (f32x4){0.f, 0.f, 0.f, 0.f}; }
#pragma unroll
        for (int ks = 0; ks < 4; ++ks) {
            bf16x8 Kf[4], Qf[4];
#pragma unroll
            for (int rt = 0; rt < 4; ++rt) { if (rt >= nti) continue; const int row = 16 * rt + c16; const bool ok = row < nvalid;
                const int rowc = ok ? row : 0;
                const bf16_t* kp = KB + (size_t)(t0 + rowc) * 1024 + kh * 128 + 8 * q + 32 * ks; const bf16_t* qp = QB + (size_t)(t0 + rowc) * 1024 + kh * 128 + 8 * q + 32 * ks;
                Kf[rt] = *(const bf16x8*)kp; Qf[rt] = *(const bf16x8*)qp;
                if (!ok) { Kf[rt] = (bf16x8){0, 0, 0, 0, 0, 0, 0, 0}; Qf[rt] = (bf16x8){0, 0, 0, 0, 0, 0, 0, 0}; } }
#pragma unroll
            for (int ti = 0; ti < 4; ++ti)
#pragma unroll
                for (int tj = 0; tj <= ti; ++tj) { if (ti >= nti) continue; const int x = ti * (ti + 1) / 2 + tj;
                    kka[x] = __builtin_amdgcn_mfma_f32_16x16x32_bf16(Kf[ti], Kf[tj], kka[x], 0, 0, 0); qka[x] = __builtin_amdgcn_mfma_f32_16x16x32_bf16(Qf[ti], Kf[tj], qka[x], 0, 0, 0); }
            asm volatile("" ::: "memory");
        }
        LDS_WAIT();
        bf16_t* tinv = TQ + (size_t)it * 8192; bf16_t* qkd = tinv + 4096;
#pragma unroll
        for (int ti = 0; ti < 4; ++ti)
#pragma unroll
            for (int tj = 0; tj < 4; ++tj) {
                if (ti >= nti) continue;
                if (tj <= ti) {
                    const int x = ti * (ti + 1) / 2 + tj;
                    const int jj = 16 * tj + c16; const float gj = gcs[jj];
#pragma unroll
                    for (int j = 0; j < 4; ++j) { const int i = 16 * ti + 4 * q + j; const float gi = gcs[i], bi = bts[i];
                        const float dec = (i >= jj) ? __expf(gi - gj) : 0.f;
                        Am[i * 68 + jj] = (i > jj) ? bi * kka[x][j] * dec : 0.f;
                        qkd[i * 64 + jj] = (bf16_t)(pk2((i >= jj) ? qka[x][j] * dec : 0.f, 0.f) & 0xffffu); }
                } else {
#pragma unroll
                    for (int j = 0; j < 4; ++j) qkd[(16 * ti + 4 * q + j) * 64 + 16 * tj + c16] = 0;
                }
                asm volatile("" ::: "memory");
            }
        LDS_WAIT();
        float X[64];
        const int lo = lane;
#define FS1(i) fs_row<i>(X, Am, tinv, lo, nvalid, nst);
#define FS4(i) FS1(i) FS1(i + 1) FS1(i + 2) FS1(i + 3)
#define FS16(i) FS4(i) FS4(i + 4) FS4(i + 8) FS4(i + 12)
        FS16(0) FS16(16) FS16(32) FS16(48)
#undef FS16
#undef FS4
#undef FS1
        LDS_WAIT();
    }
}

__device__ __forceinline__ void gdn_scan_item(Frame& F, int t0_first, int nchunks, int nvalid, int item0, int item_stride, int h, const float* s_in, float* s_out) {
    LAS bf16_t* KT = (LAS bf16_t*)F.lds;
    LAS bf16_t* ST = KT + 128 * 72;
    LAS bf16_t* RT = ST + 128 * 136;
    LAS bf16_t* VN = RT + 128 * 72;
    LAS bf16_t* VS = VN + 128 * 72;
    LAS float* ssx = (LAS float*)(VS + 128 * 72);
    const bf16_t* QB = WSP(bf16_t, OFF_QB); const bf16_t* KB = WSP(bf16_t, OFF_KB); const bf16_t* VB = WSP(bf16_t, OFF_VB); const bf16_t* Z = WSP(bf16_t, OFF_Z);
    const bf16_t* TQ = WSP(bf16_t, OFF_BIG); const float* GC = WSP(float, OFF_GC); const float* BETA = WSP(float, OFF_BETA);
    bf16_t* ON = WSP(bf16_t, OFF_ON);
    int lane = F.lane; asm volatile("" : "+v"(lane));
    const int w = F.wave, c16 = lane & 15, q = lane >> 4, ct = w >> 1, vh = w & 1, kh = h >> 1;
    f32x4 S[8];
#pragma unroll
    for (int vt = 0; vt < 8; ++vt) S[vt] = (f32x4){0.f, 0.f, 0.f, 0.f};
    if (s_in) {
#pragma unroll
        for (int vt = 0; vt < 8; ++vt)
#pragma unroll
            for (int j = 0; j < 4; ++j) S[vt][j] = s_in[(size_t)(16 * w + 4 * q + j) * 128 + 16 * vt + c16];
    }
#pragma unroll
    for (int vt = 0; vt < 8; ++vt) {
        u32x2 pk; pk.x = pk2(S[vt][0], S[vt][1]); pk.y = pk2(S[vt][2], S[vt][3]);
        *(LAS u32x2*)(ST + (16 * vt + c16) * 136 + 16 * w + 4 * q) = pk;
    }
    float on_g[4];
#pragma unroll
    for (int vt = 0; vt < 4; ++vt) on_g[vt] = F.in[15][16 * (4 * vh + vt) + c16];
    const int rowA = 16 * ct + c16; const bool rvalid = rowA < nvalid;
    const int i0 = 16 * ct + 4 * q;
    const unsigned offKQ = rowA * 1024 + 8 * q, offKT = lane * 1024 + 16 * w, offTQ = rowA * 64 + 8 * q, offV = i0 * 2048 + 64 * vh + c16;
    for (int n = 0; n < nchunks; ++n) {
        const int t0 = t0_first + n * 64; const size_t item = (size_t)item0 + (size_t)n * item_stride;
        bf16x8 Kf[4], Qf[4], Tf[2], QKf[2];
        const bf16_t* kb_ = KB + (size_t)t0 * 1024 + kh * 128; const bf16_t* qb_ = QB + (size_t)t0 * 1024 + kh * 128; const bf16_t* tq_ = TQ + item * 8192;
        const bf16_t* vb_ = VB + (size_t)t0 * 2048 + h * 128; const bf16_t* zb_ = Z + (size_t)t0 * 2048 + h * 128;
        u32x4 k0, k1;
        { const u32x4* kp = (const u32x4*)(kb_ + offKT); k0 = kp[0]; k1 = kp[1]; }
#pragma unroll
        for (int ks = 0; ks < 4; ++ks) { Kf[ks] = *(const bf16x8*)(kb_ + (offKQ + 32u * ks)); Qf[ks] = *(const bf16x8*)(qb_ + (offKQ + 32u * ks)); }
        const f32x4 gc4 = *(const f32x4*)(GC + item * 64 + (unsigned)i0), beta4 = *(const f32x4*)(BETA + item * 64 + (unsigned)i0);
        const float gcl = GC[item * 64 + 63];
        typedef unsigned short us2 __attribute__((ext_vector_type(2)));
        us2 vvr[4][2], zzr[4][2];
#pragma unroll
        for (int vt = 0; vt < 4; ++vt)
#pragma unroll
            for (int j2 = 0; j2 < 2; ++j2) { us2 x_; x_.x = vb_[offV + (unsigned)((2 * j2) * 2048 + vt * 16)]; x_.y = vb_[offV + (unsigned)((2 * j2 + 1) * 2048 + vt * 16)]; vvr[vt][j2] = x_; }
        float egc[4], edl[4];
#pragma unroll
        for (int j = 0; j < 4; ++j) { egc[j] = __expf(gc4[j]); edl[j] = __expf(gcl - gc4[j]); }
        const float egl = __expf(gcl);
        LBAR();
        { LAS bf16_t* kt = KT + (16 * w) * 72 + lane;
          kt[0 * 72] = (bf16_t)(k0.x & 0xffff); kt[1 * 72] = (bf16_t)(k0.x >> 16); kt[2 * 72] = (bf16_t)(k0.y & 0xffff); kt[3 * 72] = (bf16_t)(k0.y >> 16);
          kt[4 * 72] = (bf16_t)(k0.z & 0xffff); kt[5 * 72] = (bf16_t)(k0.z >> 16); kt[6 * 72] = (bf16_t)(k0.w & 0xffff); kt[7 * 72] = (bf16_t)(k0.w >> 16);
          kt[8 * 72] = (bf16_t)(k1.x & 0xffff); kt[9 * 72] = (bf16_t)(k1.x >> 16); kt[10 * 72] = (bf16_t)(k1.y & 0xffff); kt[11 * 72] = (bf16_t)(k1.y >> 16);
          kt[12 * 72] = (bf16_t)(k1.z & 0xffff); kt[13 * 72] = (bf16_t)(k1.z >> 16); kt[14 * 72] = (bf16_t)(k1.w & 0xffff); kt[15 * 72] = (bf16_t)(k1.w >> 16); }
#pragma unroll
        for (int ks = 0; ks < 2; ++ks) { Tf[ks] = *(const bf16x8*)(tq_ + (offTQ + 32u * ks)); QKf[ks] = *(const bf16x8*)(tq_ + (offTQ + 4096u + 32u * ks)); }
        f32x4 ksa[4], qsa[4];
#pragma unroll
        for (int vt = 0; vt < 4; ++vt) { ksa[vt] = (f32x4){0.f, 0.f, 0.f, 0.f}; qsa[vt] = (f32x4){0.f, 0.f, 0.f, 0.f};
#pragma unroll
            for (int ks = 0; ks < 4; ++ks) { const bf16x8 Sf = *(const LAS bf16x8*)(ST + (16 * (4 * vh + vt) + c16) * 136 + 32 * ks + 8 * q);
                ksa[vt] = __builtin_amdgcn_mfma_f32_16x16x32_bf16(Kf[ks], Sf, ksa[vt], 0, 0, 0); qsa[vt] = __builtin_amdgcn_mfma_f32_16x16x32_bf16(Qf[ks], Sf, qsa[vt], 0, 0, 0); } }
#pragma unroll
        for (int vt = 0; vt < 4; ++vt) { float r[4];
#pragma unroll
            for (int j = 0; j < 4; ++j) r[j] = beta4[j] * (bf2f(vvr[vt][j >> 1][j & 1]) - egc[j] * ksa[vt][j]);
            u32x2 pk; pk.x = pk2(r[0], r[1]); pk.y = pk2(r[2], r[3]);
            *(LAS u32x2*)(RT + (16 * (4 * vh + vt) + c16) * 72 + i0) = pk; }
        LBAR();
#pragma unroll
        for (int vt = 0; vt < 4; ++vt)
#pragma unroll
            for (int j2 = 0; j2 < 2; ++j2) { us2 x_; x_.x = zb_[offV + (unsigned)((2 * j2) * 2048 + vt * 16)]; x_.y = zb_[offV + (unsigned)((2 * j2 + 1) * 2048 + vt * 16)]; zzr[vt][j2] = x_; }
        f32x4 vn[4];
#pragma unroll
        for (int vt = 0; vt < 4; ++vt) { vn[vt] = (f32x4){0.f, 0.f, 0.f, 0.f};
#pragma unroll
            for (int ks = 0; ks < 2; ++ks) { const bf16x8 Rf = *(const LAS bf16x8*)(RT + (16 * (4 * vh + vt) + c16) * 72 + 32 * ks + 8 * q);
                vn[vt] = __builtin_amdgcn_mfma_f32_16x16x32_bf16(Tf[ks], Rf, vn[vt], 0, 0, 0); }
            u32x2 pa, pb; pa.x = pk2(vn[vt][0], vn[vt][1]); pa.y = pk2(vn[vt][2], vn[vt][3]);
            pb.x = pk2(vn[vt][0] * edl[0], vn[vt][1] * edl[1]); pb.y = pk2(vn[vt][2] * edl[2], vn[vt][3] * edl[3]);
            *(LAS u32x2*)(VN + (16 * (4 * vh + vt) + c16) * 72 + i0) = pa; *(LAS u32x2*)(VS + (16 * (4 * vh + vt) + c16) * 72 + i0) = pb; }
        LBAR();
        float ss[4] = {0.f, 0.f, 0.f, 0.f};
#pragma unroll
        for (int vt = 0; vt < 4; ++vt) {
#pragma unroll
            for (int j = 0; j < 4; ++j) qsa[vt][j] *= egc[j];
#pragma unroll
            for (int ks = 0; ks < 2; ++ks) { const bf16x8 Vf = *(const LAS bf16x8*)(VN + (16 * (4 * vh + vt) + c16) * 72 + 32 * ks + 8 * q);
                qsa[vt] = __builtin_amdgcn_mfma_f32_16x16x32_bf16(QKf[ks], Vf, qsa[vt], 0, 0, 0); }
#pragma unroll
            for (int j = 0; j < 4; ++j) ss[j] += qsa[vt][j] * qsa[vt][j]; }
#pragma unroll
        for (int j = 0; j < 4; ++j) { ss[j] += __shfl_xor(ss[j], 1); ss[j] += __shfl_xor(ss[j], 2); ss[j] += __shfl_xor(ss[j], 4); ss[j] += __shfl_xor(ss[j], 8); }
        if (c16 == 0) *(LAS f32x4*)(ssx + w * 16 + 4 * q) = (f32x4){ss[0], ss[1], ss[2], ss[3]};
        LBAR();
        { const f32x4 sa = *(const LAS f32x4*)(ssx + w * 16 + 4 * q), sb = *(const LAS f32x4*)(ssx + (w ^ 1) * 16 + 4 * q);
          bf16_t* ob_ = ON + (size_t)t0 * 2048 + h * 128;
#pragma unroll
          for (int j = 0; j < 4; ++j) { const float rstd = rsqrtf((sa[j] + sb[j]) * (1.0f / 128.0f) + EPS);
#pragma unroll
              for (int vt = 0; vt < 4; ++vt) ob_[offV + (unsigned)(j * 2048 + vt * 16)] = (bf16_t)(pk2(qsa[vt][j] * rstd * on_g[vt] * silu_f(bf2f(zzr[vt][j >> 1][j & 1])), 0.f) & 0xffffu); } }
        bf16x8 KTf[2][2];
#pragma unroll
        for (int kk = 0; kk < 2; ++kk)
#pragma unroll
            for (int ks = 0; ks < 2; ++ks) KTf[kk][ks] = *(const LAS bf16x8*)(KT + (16 * (2 * ct + kk) + c16) * 72 + 32 * ks + 8 * q);
#pragma unroll
        for (int vtl = 0; vtl < 4; ++vtl) { const int vt = 4 * vh + vtl; bf16x8 Vf[2];
#pragma unroll
            for (int ks = 0; ks < 2; ++ks) Vf[ks] = *(const LAS bf16x8*)(VS + (16 * vt + c16) * 72 + 32 * ks + 8 * q);
#pragma unroll
            for (int kk = 0; kk < 2; ++kk) { const int x = kk * 4 + vtl; S[x] = S[x] * egl;
#pragma unroll
                for (int ks = 0; ks < 2; ++ks) S[x] = __builtin_amdgcn_mfma_f32_16x16x32_bf16(KTf[kk][ks], Vf[ks], S[x], 0, 0, 0);
                u32x2 pk; pk.x = pk2(S[x][0], S[x][1]); pk.y = pk2(S[x][2], S[x][3]);
                *(LAS u32x2*)(ST + (16 * vt + c16) * 136 + 16 * (2 * ct + kk) + 4 * q) = pk; } }
    }
#pragma unroll
    for (int kk = 0; kk < 2; ++kk)
#pragma unroll
        for (int vtl = 0; vtl < 4; ++vtl)
#pragma unroll
            for (int j = 0; j < 4; ++j) s_out[(size_t)(16 * (2 * ct + kk) + 4 * q + j) * 128 + 16 * (4 * vh + vtl) + c16] = S[kk * 4 + vtl][j];
    LBAR();
}
__device__ __forceinline__ void gdn_sample_item(Frame& F, int p) {
    LAS bf16_t* KT = (LAS bf16_t*)F.lds;
    LAS bf16_t* ST = KT + 128 * 72;
    LAS bf16_t* RT = ST + 128 * 136;
    LAS bf16_t* VS = RT + 128 * 72 * 2;
    LAS float* ssx = (LAS float*)(VS + 128 * 72);
    const bf16_t* QB = WSP(bf16_t, OFF_QB); const bf16_t* KB = WSP(bf16_t, OFF_KB); const bf16_t* VB = WSP(bf16_t, OFF_VB); const bf16_t* Z = WSP(bf16_t, OFF_Z);
    const bf16_t* TQ = WSP(bf16_t, OFF_BIG); const float* GC = WSP(float, OFF_GC); const float* BETA = WSP(float, OFF_BETA);
    bf16_t* ON = WSP(bf16_t, OFF_ON);
    int lane = F.lane; asm volatile("" : "+v"(lane));
    const int w = F.wave, c16 = lane & 15, q = lane >> 4;
    const int s_ = p >> 4, h = p & 15, kh = h >> 1, t0 = TP + s_ * 8; const size_t item = 4096 + (size_t)p;
    const float* s_in = F.in[4] + (size_t)p * 16384; float* s_out = F.out + O_RECS + (size_t)p * 16384;
    f32x4 S[8];
#pragma unroll
    for (int vt = 0; vt < 8; ++vt)
#pragma unroll
        for (int j = 0; j < 4; ++j) S[vt][j] = __builtin_nontemporal_load(s_in + (size_t)(16 * w + 4 * q + j) * 128 + 16 * vt + c16);
    const bool rvalid = c16 < 8; const int rowc = rvalid ? c16 : 0;
    bf16x8 Kf[4], Qf[4], Tf, QKf;
    { const bf16_t* kp = KB + (size_t)(t0 + rowc) * 1024 + kh * 128 + 8 * q; const bf16_t* qp = QB + (size_t)(t0 + rowc) * 1024 + kh * 128 + 8 * q;
#pragma unroll
      for (int ks = 0; ks < 4; ++ks) { Kf[ks] = *(const bf16x8*)(kp + 32 * ks); Qf[ks] = *(const bf16x8*)(qp + 32 * ks); }
      if (!rvalid) {
#pragma unroll
          for (int ks = 0; ks < 4; ++ks) { Kf[ks] = (bf16x8){0, 0, 0, 0, 0, 0, 0, 0}; Qf[ks] = (bf16x8){0, 0, 0, 0, 0, 0, 0, 0}; } }
      const bf16_t* tp = TQ + item * 8192 + c16 * 64 + 8 * q; Tf = *(const bf16x8*)tp; QKf = *(const bf16x8*)(tp + 4096); }
    const int i0 = 4 * q;
    const f32x4 gc4 = *(const f32x4*)(GC + item * 64 + i0), beta4 = *(const f32x4*)(BETA + item * 64 + i0);
    const float gcl = GC[item * 64 + 63];
    float vv[4], zz[4];
#pragma unroll
    for (int j = 0; j < 4; ++j) { const bool ok = (i0 + j) < 8; const size_t o = (size_t)(t0 + (ok ? i0 + j : 0)) * 2048 + h * 128 + 16 * w + c16;
        const float v_ = bf2f(VB[o]), z_ = bf2f(Z[o]); vv[j] = ok ? v_ : 0.f; zz[j] = ok ? z_ : 0.f; }
    const float on_g = F.in[15][16 * w + c16];
    if (lane < 32) { u32x4 k0 = {0u, 0u, 0u, 0u}, k1 = {0u, 0u, 0u, 0u};
        { const u32x4* kp = (const u32x4*)(KB + (size_t)(t0 + (lane < 8 ? lane : 0)) * 1024 + kh * 128 + 16 * w); k0 = kp[0]; k1 = kp[1]; if (lane >= 8) { k0 = (u32x4){0u, 0u, 0u, 0u}; k1 = (u32x4){0u, 0u, 0u, 0u}; } }
        LAS bf16_t* kt = KT + (16 * w) * 72 + lane;
        kt[0 * 72] = (bf16_t)(k0.x & 0xffff); kt[1 * 72] = (bf16_t)(k0.x >> 16); kt[2 * 72] = (bf16_t)(k0.y & 0xffff); kt[3 * 72] = (bf16_t)(k0.y >> 16);
        kt[4 * 72] = (bf16_t)(k0.z & 0xffff); kt[5 * 72] = (bf16_t)(k0.z >> 16); kt[6 * 72] = (bf16_t)(k0.w & 0xffff); kt[7 * 72] = (bf16_t)(k0.w >> 16);
        kt[8 * 72] = (bf16_t)(k1.x & 0xffff); kt[9 * 72] = (bf16_t)(k1.x >> 16); kt[10 * 72] = (bf16_t)(k1.y & 0xffff); kt[11 * 72] = (bf16_t)(k1.y >> 16);
        kt[12 * 72] = (bf16_t)(k1.z & 0xffff); kt[13 * 72] = (bf16_t)(k1.z >> 16); kt[14 * 72] = (bf16_t)(k1.w & 0xffff); kt[15 * 72] = (bf16_t)(k1.w >> 16); }
#pragma unroll
    for (int vt = 0; vt < 8; ++vt) { u32x2 pk; pk.x = pk2(S[vt][0], S[vt][1]); pk.y = pk2(S[vt][2], S[vt][3]);
        *(LAS u32x2*)(ST + (16 * vt + c16) * 136 + 16 * w + 4 * q) = pk; }
    float egc[4], edl[4];
#pragma unroll
    for (int j = 0; j < 4; ++j) { egc[j] = __expf(gc4[j]); edl[j] = __expf(gcl - gc4[j]); }
    const float egl = __expf(gcl);
    LBAR();
    f32x4 ksa = {0.f, 0.f, 0.f, 0.f}, qsa = {0.f, 0.f, 0.f, 0.f};
#pragma unroll
    for (int ks = 0; ks < 4; ++ks) { const bf16x8 Sf = *(const LAS bf16x8*)(ST + (16 * w + c16) * 136 + 32 * ks + 8 * q);
        ksa = __builtin_amdgcn_mfma_f32_16x16x32_bf16(Kf[ks], Sf, ksa, 0, 0, 0); qsa = __builtin_amdgcn_mfma_f32_16x16x32_bf16(Qf[ks], Sf, qsa, 0, 0, 0); }
    { float r[4];
#pragma unroll
      for (int j = 0; j < 4; ++j) r[j] = beta4[j] * (vv[j] - egc[j] * ksa[j]);
      u32x2 pk; pk.x = pk2(r[0], r[1]); pk.y = pk2(r[2], r[3]);
      if (q < 2) *(LAS u32x2*)(RT + (16 * w + c16) * 72 + i0) = pk;
      else *(LAS u32x2*)(RT + (16 * w + c16) * 72 + i0) = (u32x2){0u, 0u};
      *(LAS u32x2*)(RT + (16 * w + c16) * 72 + 16 + i0) = (u32x2){0u, 0u}; }
    LDS_WAIT();
    f32x4 vn = {0.f, 0.f, 0.f, 0.f};
    { const bf16x8 Rf = *(const LAS bf16x8*)(RT + (16 * w + c16) * 72 + 8 * q);
      vn = __builtin_amdgcn_mfma_f32_16x16x32_bf16(Tf, Rf, vn, 0, 0, 0); }
    { u32x2 pa, pb; pa.x = pk2(vn[0], vn[1]); pa.y = pk2(vn[2], vn[3]);
      pb.x = pk2(vn[0] * edl[0], vn[1] * edl[1]); pb.y = pk2(vn[2] * edl[2], vn[3] * edl[3]);
      if (q >= 2) { pa = (u32x2){0u, 0u}; pb = (u32x2){0u, 0u}; }
      LAS bf16_t* vnr = RT + 128 * 72 + (16 * w + c16) * 72;
      *(LAS u32x2*)(vnr + i0) = pa; *(LAS u32x2*)(vnr + 16 + i0) = (u32x2){0u, 0u};
      *(LAS u32x2*)(VS + (16 * w + c16) * 72 + i0) = pb; *(LAS u32x2*)(VS + (16 * w + c16) * 72 + 16 + i0) = (u32x2){0u, 0u}; }
    LDS_WAIT();
#pragma unroll
    for (int j = 0; j < 4; ++j) qsa[j] *= egc[j];
    { const bf16x8 Vf = *(const LAS bf16x8*)(RT + 128 * 72 + (16 * w + c16) * 72 + 8 * q);
      qsa = __builtin_amdgcn_mfma_f32_16x16x32_bf16(QKf, Vf, qsa, 0, 0, 0); }
    float ss[4];
#pragma unroll
    for (int j = 0; j < 4; ++j) { ss[j] = qsa[j] * qsa[j]; ss[j] += __shfl_xor(ss[j], 1); ss[j] += __shfl_xor(ss[j], 2); ss[j] += __shfl_xor(ss[j], 4); ss[j] += __shfl_xor(ss[j], 8); }
    if (c16 == 0) *(LAS f32x4*)(ssx + w * 16 + 4 * q) = (f32x4){ss[0], ss[1], ss[2], ss[3]};
    LBAR();
    if (q < 2) {
        f32x4 tot = {0.f, 0.f, 0.f, 0.f};
#pragma unroll
        for (int ww = 0; ww < 8; ++ww) tot = tot + *(const LAS f32x4*)(ssx + ww * 16 + 4 * q);
#pragma unroll
        for (int j = 0; j < 4; ++j) { const float rstd = rsqrtf(tot[j] * (1.0f / 128.0f) + EPS);
            ON[(size_t)(t0 + i0 + j) * 2048 + h * 128 + 16 * w + c16] = (bf16_t)(pk2(qsa[j] * rstd * on_g * silu_f(zz[j]), 0.f) & 0xffffu); }
    }
    const bf16x8 KTf = *(const LAS bf16x8*)(KT + (16 * w + c16) * 72 + 8 * q);
#pragma unroll
    for (int vt = 0; vt < 8; ++vt) { S[vt] = S[vt] * egl;
        const bf16x8 Vf = *(const LAS bf16x8*)(VS + (16 * vt + c16) * 72 + 8 * q);
        S[vt] = __builtin_amdgcn_mfma_f32_16x16x32_bf16(KTf, Vf, S[vt], 0, 0, 0); }
#pragma unroll
    for (int vt = 0; vt < 8; ++vt)
#pragma unroll
        for (int j = 0; j < 4; ++j) __builtin_nontemporal_store(S[vt][j], s_out + (size_t)(16 * w + 4 * q + j) * 128 + 16 * vt + c16);
}
__device__ __forceinline__ void gdn_scan_phase(Frame& F, bool only_prompt) {
    for (int p = F.blk; p < 128; p += F.G) { const int b = p >> 4, h = p & 15;
        gdn_scan_item(F, b * SEQ, 32, 64, b * 512 + h, 16, h, nullptr, F.out + O_RECP + (size_t)p * 16384); }
    const int sblk = (F.G >= 256) ? F.blk - 128 : F.blk, sG = (F.G >= 256) ? F.G - 128 : F.G;
    if (sblk >= 0 && !only_prompt)
        for (int p = sblk; p < 2048; p += sG) gdn_sample_item(F, p);
    if (sblk >= 0 && !only_prompt) { LBAR(); transpose_items(F, true, sblk * 8 + F.wave, sG * 8); }
}

__device__ __forceinline__ void run_gemm_ffn_in(Frame& F, int ly) {
    pg8::Gemm<1024, 1024, 0> g{WSP(bf16_t, OFF_H), WSP(bf16_t, OFF_WFI) + (size_t)ly * NFI * 1024};
    pg8::StaticOrder<T / 256, NFI / 256, 16, 0, 0> S; S.init(F.G, F.blk);
    pg8::EpiSwiGLU E{WSP(bf16_t, OFF_BIG)};
    pg8::gemm_phase(F.lds, g, S, E, F.tid);
}
__device__ __forceinline__ void run_gemm_ffn_out(Frame& F, int ly) {
    pg8::Gemm<DFF, DFF, 0> g{WSP(bf16_t, OFF_BIG), WSP(bf16_t, OFF_WFO) + (size_t)ly * 1024 * DFF};
    pg8::StaticOrder<64, 4, 44, 4, 11> S; S.init(F.G, F.blk);
    pg8::EpiF32Scale E{WSP(float, OFF_MR), 1024, WSP(float, OFF_Z), TP};
    pg8::gemm_phase(F.lds, g, S, E, F.tid);
}

__global__ void __launch_bounds__(512, 2) fwd_megakernel(Args a) {
    extern __shared__ __attribute__((aligned(16))) unsigned char lds_raw[];
    cg::grid_group grid = cg::this_grid();
    Frame F;
    F.lds = (LAS unsigned char*)lds_raw;
    volatile LAS unsigned* xb_st = (volatile LAS unsigned*)(F.lds + (LDS_BYTES - 16));
    unsigned* xb_bar = (unsigned*)(a.ws + OFF_BAR);
    if (threadIdx.x == 0) { xb_st[0] = 0u; xb_st[1] = 0u; (void)xb_add(&xb_bar[XB_XCNT(xb_xcc_id())], 1u); }
    __syncthreads();
    if (a.ph_lo < 0) grid.sync();
#pragma unroll
    for (int i = 0; i < 19; ++i) F.in[i] = a.in[i];
    F.out = a.out; F.ws = a.ws;
#ifndef DUP_MASK
#define DUP_MASK 0
#endif
    for (int ph2 = 2 * a.ph_lo; ph2 < 2 * a.ph_hi; ++ph2) {
        const int ph = ph2 >> 1;
        if ((ph2 & 1) && !((DUP_MASK >> ph) & 1)) continue;
        { int t_ = threadIdx.x; asm volatile("" : "+v"(t_));
          int b_ = blockIdx.x, g_ = gridDim.x; asm volatile("" : "+s"(b_), "+s"(g_));
          F.blk = b_; F.G = g_; F.NGW = g_ * 8;
          F.tid = t_; F.lane = t_ & 63; F.wave = __builtin_amdgcn_readfirstlane(t_ >> 6); F.gw = F.blk * 8 + F.wave; }
        switch (ph) {
        case 0: if (PHON(0)) prep_phase(F); break;
        case 1: if (PHON(1)) { pg8::Gemm<1024, 256, 256> g{WSP(bf16_t, OFF_DB), WSP(bf16_t, OFF_WP)};
                  pg8::StaticOrder<T / 256, 4, 4, 0, 0> S; S.init(F.G, F.blk);
                  pg8::EpiF32Scale E{WSP(float, OFF_MR), 1024, nullptr, 0};
                  pg8::gemm_phase(F.lds, g, S, E, F.tid); } break;
        case 2: if (PHON(2)) row_phase<0>(F, F.in[0], F.in[1], F.in[6], F.in[7], F.in[10], false); break;
        case 3: if (PHON(3)) run_gemm_ffn_in(F, 0); break;
        case 4: if (PHON(4)) run_gemm_ffn_out(F, 0); break;
        case 5: if (PHON(5)) row_phase<11>(F, nullptr, nullptr, F.in[8], F.in[5] + D, nullptr, false); break;
        case 6: if (PHON(6)) { pg8::Gemm<1024, 1024, 0> g{WSP(bf16_t, OFF_H), WSP(bf16_t, OFF_WGI)};
                  pg8::StaticOrder<T / 256, NGIP / 256, 16, 0, 0> S; S.init(F.G, F.blk);
                  pg8::EpiProj E{WSP(bf16_t, OFF_BIG), WSP(bf16_t, OFF_Z), WSP(bf16_t, OFF_BA)};
                  pg8::gemm_phase(F.lds, g, S, E, F.tid); } break;
        case 7: if (PHON(7)) conv_phase(F); break;
        case 8: if (PHON(8)) gdn_pre_phase(F); break;
        case 9: if (PHON(9)) gdn_scan_phase(F, false); break;
        case 10: if (PHON(10)) { pg8::Gemm<2048, 2048, 0> g{WSP(bf16_t, OFF_ON), WSP(bf16_t, OFF_WGO)};
                   pg8::StaticOrder<64, 4, 32, 4, 8> S; S.init(F.G, F.blk);
                   pg8::EpiF32Scale E{WSP(float, OFF_MR), 1024, WSP(float, OFF_Z), TP};
                   pg8::gemm_phase(F.lds, g, S, E, F.tid); } break;
        case 11: if (PHON(11)) row_phase<8>(F, nullptr, nullptr, F.in[6] + D, F.in[7] + D, nullptr, false); break;
        case 12: if (PHON(12)) run_gemm_ffn_in(F, 1); break;
        case 13: if (PHON(13)) run_gemm_ffn_out(F, 1); break;
        case 14: if (PHON(14)) row_phase<11>(F, nullptr, nullptr, F.in[8] + D, nullptr, nullptr, true); break;
        default: break;
        }
        if (ph2 + 1 < 2 * a.ph_hi) xcd_barrier(xb_bar, xb_st);
    }
}

extern "C" void kernel_launch(void* const* d_in, const int* in_sizes, int n_in, void* d_out, int out_size, void* d_ws, size_t ws_size, hipStream_t stream) {
    static int grid = 0;
    if (grid == 0) {
        if (n_in != 19 || ws_size < WS_END) { fprintf(stderr, "kernel_launch: unexpected n_in %d / ws %zu (need %zu)\n", n_in, ws_size, (size_t)WS_END); grid = -1; return; }
        int dev = 0, cus = 0, per_cu = 0;
        (void)hipGetDevice(&dev); (void)hipDeviceGetAttribute(&cus, hipDeviceAttributeMultiprocessorCount, dev);
        if (hipFuncSetAttribute((const void*)fwd_megakernel, hipFuncAttributeMaxDynamicSharedMemorySize, LDS_BYTES) != hipSuccess) { fprintf(stderr, "kernel_launch: hipFuncSetAttribute failed\n"); grid = -1; return; }
        if (hipOccupancyMaxActiveBlocksPerMultiprocessor(&per_cu, (const void*)fwd_megakernel, 512, LDS_BYTES) != hipSuccess || per_cu < 1) { fprintf(stderr, "kernel_launch: occupancy query says %d\n", per_cu); per_cu = 1; }
        (void)hipGetLastError();
        grid = cus;
    }
    if (grid < 0) return;
    Args a{};
    for (int i = 0; i < 19; ++i) a.in[i] = (const float*)d_in[i];
    a.out = (float*)d_out; a.ws = (unsigned char*)d_ws;
#ifndef PER_PHASE_LAUNCH
#define PER_PHASE_LAUNCH 0
#endif
    const int step = PER_PHASE_LAUNCH ? 1 : NPHASE;
    if (hipMemsetAsync((unsigned char*)d_ws + OFF_BAR, 0, 16384, stream) != hipSuccess) { fprintf(stderr, "kernel_launch: memset of barrier words failed\n"); return; }
#ifndef PH_END
#define PH_END NPHASE
#endif
    for (int p0 = 0; p0 < PH_END; p0 += step) {
        a.ph_lo = p0; a.ph_hi = (p0 + step < PH_END) ? p0 + step : PH_END;
        void* args[] = {&a};
        hipError_t e = hipLaunchCooperativeKernel((const void*)fwd_megakernel, dim3(grid), dim3(512), args, LDS_BYTES, stream);
        if (e != hipSuccess) { fprintf(stderr, "cooperative launch failed: %s (grid %d)\n", hipGetErrorString(e), grid); break; }
    }
}
```

```cpp
#include <hip/hip_runtime.h>
#include <hip/hip_cooperative_groups.h>
#include <cstdio>
namespace cg = cooperative_groups;

#define LAS __attribute__((address_space(3)))
typedef unsigned short bf16_t;
typedef short bf16x8 __attribute__((ext_vector_type(8)));
typedef float f32x4 __attribute__((ext_vector_type(4)));
typedef float f32x2 __attribute__((ext_vector_type(2)));
typedef unsigned u32x4 __attribute__((ext_vector_type(4)));
typedef unsigned u32x2 __attribute__((ext_vector_type(2)));

constexpr int D = 1024, TP = 16384, TS = 1024, T = TP + TS, SEQ = 2048;
constexpr int DFF = 2816, NFI = 5632, NGI = 6176, NGIP = 6400;
constexpr float EPS = 1e-6f;
constexpr int LDS_BYTES = 147456;
constexpr int NPHASE = 15;
#ifndef ONLY
#define ONLY -1
#endif
#define PHON(n) (ONLY < 0 || ONLY == (n))

constexpr size_t SZ_TD2 = (size_t)T * 1024 * 2;
constexpr size_t OFF_WP = 0;
constexpr size_t OFF_WFI = OFF_WP + 524288;
constexpr size_t OFF_WFO = OFF_WFI + 23068672;
constexpr size_t OFF_WGI = OFF_WFO + 11534336;
constexpr size_t OFF_WGO = OFF_WGI + 13107200;
constexpr size_t OFF_DB = OFF_WGO + 4194304;
constexpr size_t OFF_H = OFF_DB + SZ_TD2;
constexpr size_t OFF_ON = OFF_DB;
constexpr size_t OFF_MR = OFF_H + SZ_TD2;
constexpr size_t OFF_QB = OFF_MR, OFF_KB = OFF_MR + SZ_TD2;
constexpr size_t OFF_BIG = OFF_MR + 2 * SZ_TD2;
constexpr size_t OFF_Z = OFF_BIG + 142606336;
constexpr size_t OFF_BA = OFF_Z + 71303168;
constexpr size_t OFF_VB = OFF_BA + 8912896;
constexpr size_t OFF_GC = OFF_VB + 71303168;
constexpr size_t OFF_BETA = OFF_GC + 1572864;
constexpr size_t OFF_BAR = OFF_BETA + 1572864;
constexpr size_t OFF_XB = OFF_BAR + 16384;
constexpr size_t WS_END = OFF_XB + SZ_TD2;

constexpr size_t O_Y = 0;
constexpr size_t O_POOLP = (size_t)T * 1024;
constexpr size_t O_POOLS = O_POOLP + 8 * 15 * 1024;
constexpr size_t O_CONVP = O_POOLS + 128 * 15 * 1024;
constexpr size_t O_CONVS = O_CONVP + 8 * 3 * 4096;
constexpr size_t O_RECP = O_CONVS + 128 * 3 * 4096;
constexpr size_t O_RECS = O_RECP + (size_t)8 * 16 * 128 * 128;

struct Args { const float* in[19]; float* out; unsigned char* ws; int ph_lo, ph_hi; };

typedef __bf16 bf16x2_t __attribute__((ext_vector_type(2)));
__device__ __forceinline__ unsigned pk2(float lo, float hi) { const f32x2 v = {lo, hi}; const bf16x2_t r = __builtin_convertvector(v, bf16x2_t); return __builtin_bit_cast(unsigned, r); }
__device__ __forceinline__ float bf2f(bf16_t b) { return __uint_as_float(((unsigned)b) << 16); }
__device__ __forceinline__ float bflo(unsigned w) { return __uint_as_float(w << 16); }
__device__ __forceinline__ float bfhi(unsigned w) { return __uint_as_float(w & 0xffff0000u); }
__device__ __forceinline__ float silu_f(float x) { return x * __builtin_amdgcn_rcpf(1.0f + __expf(-x)); }
__device__ __forceinline__ float wave_sum(float v) {
#pragma unroll
    for (int o = 1; o < 64; o <<= 1) v += __shfl_xor(v, o);
    return v;
}
#define LDS_WAIT() asm volatile("s_waitcnt lgkmcnt(0)" ::: "memory")
#define LBAR() do { asm volatile("s_waitcnt lgkmcnt(0)" ::: "memory"); __builtin_amdgcn_s_barrier(); asm volatile("" ::: "memory"); } while (0)

#define XB_TMO      128
#define XB_XCNT(j)  (256  + 64 * (j))
#define XB_XSUB(j)  (1280 + 64 * (j))
#define XB_XGEN(j)  (2304 + 64 * (j))
#define XB_TOP      3328
#define XB_TOPGEN   3392
#define XCD_BAR_WORDS 3456
#define XB_SPIN_CAP (1u << 18)
__device__ __forceinline__ unsigned xb_ld(unsigned* p)              { return __hip_atomic_load(p, __ATOMIC_RELAXED, __HIP_MEMORY_SCOPE_AGENT); }
__device__ __forceinline__ unsigned xb_add(unsigned* p, unsigned v) { return __hip_atomic_fetch_add(p, v, __ATOMIC_RELAXED, __HIP_MEMORY_SCOPE_AGENT); }
__device__ __forceinline__ unsigned xb_xcc_id() { return (unsigned)__builtin_amdgcn_s_getreg((3 << 11) | 20) & 0xFu; }
#define XB_SPIN(cond, bar) do { unsigned _sp = 0; while (cond) { __builtin_amdgcn_s_sleep(1); \
    if ((++_sp & 255u) == 0u) { if (xb_ld(&(bar)[XB_TMO])) break; if (_sp > XB_SPIN_CAP) { atomicAdd(&(bar)[XB_TMO], 1u); break; } } } } while (0)
__device__ __forceinline__ void xcd_barrier_complete(unsigned* bar, unsigned x, unsigned& nloc, unsigned& nx) {
    const unsigned G = gridDim.x * gridDim.y * gridDim.z;
    unsigned sum, cnt, mine, sp = 0u;
    for (;;) {
        sum = 0u; cnt = 0u; mine = 0u;
#pragma unroll
        for (unsigned j = 0; j < 16; ++j) { const unsigned c = xb_ld(&bar[XB_XCNT(j)]); sum += c; cnt += (c > 0u) ? 1u : 0u; mine = (j == x) ? c : mine; }
        if (sum == G) break;
        __builtin_amdgcn_s_sleep(1);
        if ((++sp & 255u) == 0u) { if (xb_ld(&bar[XB_TMO])) break; if (sp > XB_SPIN_CAP) { atomicAdd(&bar[XB_TMO], 1u); break; } }
    }
    nloc = mine > 0u ? mine : 1u; nx = cnt > 0u ? cnt : 1u;
}
__device__ __forceinline__ void xcd_barrier(unsigned* bar, volatile LAS unsigned* st) {
    asm volatile("s_waitcnt vmcnt(0)" ::: "memory");
    __syncthreads();
    if (threadIdx.x == 0) {
        const unsigned x = xb_xcc_id();
        __builtin_amdgcn_s_waitcnt(0);
        unsigned nloc = st[0], nx = st[1];
        if (nloc == 0u) { xcd_barrier_complete(bar, x, nloc, nx); st[0] = nloc; st[1] = nx; }
        const unsigned old = xb_add(&bar[XB_XSUB(x)], 1u);
        const unsigned gen = old / nloc;
        if (old + 1u == (gen + 1u) * nloc) {
            __builtin_amdgcn_fence(__ATOMIC_RELEASE, "agent");
            asm volatile("s_waitcnt vmcnt(0)" ::: "memory");
            const unsigned og = xb_add(&bar[XB_TOP], 1u);
            const unsigned tg = og / nx;
            if (og + 1u == (tg + 1u) * nx) xb_add(&bar[XB_TOPGEN], 1u);
            else XB_SPIN(xb_ld(&bar[XB_TOPGEN]) == tg, bar);
            __builtin_amdgcn_fence(__ATOMIC_ACQUIRE, "agent");
            xb_add(&bar[XB_XGEN(x)], 1u);
            asm volatile("s_waitcnt vmcnt(0)" ::: "memory");
        } else {
            XB_SPIN(xb_ld(&bar[XB_XGEN(x)]) == gen, bar);
            __builtin_amdgcn_fence(__ATOMIC_ACQUIRE, "agent");
            asm volatile("s_waitcnt vmcnt(0)" ::: "memory");
        }
    }
    __syncthreads();
}

namespace pg8 {
constexpr int BM = 256, BK = 64, HALF = 128, HTB = HALF * BK * 2, NXCD = 8, WGM = 8;
__device__ __forceinline__ int lds_byte(int r, int c) { const int st = (r >> 4) * 2 + (c >> 5), rr = r & 15, cc = c & 31, ob = rr * 64 + cc * 2; return st * 1024 + (ob ^ (((ob >> 9) & 1) << 5)); }
__device__ __forceinline__ void stage_rc(int b, int& R, int& C) { const int st = b / 1024, sb = b % 1024, swz = sb ^ (((sb >> 9) & 1) << 5); R = (st >> 1) * 16 + swz / 64; C = (st & 1) * 32 + (swz % 64) / 2; }
__device__ __forceinline__ int perm32(int rho) { const int n = rho >> 4, i = rho & 15; return 8 * (i >> 2) + 4 * n + (i & 3); }
struct Unit { int pm, pn, k0, nt, part; };
template <int LDA, int LDB, int APN> struct Gemm { const bf16_t* A; const bf16_t* Bt; static constexpr int lda = LDA, ldb = LDB, a_pn_off = APN; };
template <int nM, int nN, int ntK, int nMs, int nsplit>
struct StaticOrder {
    static constexpr int nwg = nM * nN, ntS = nsplit ? ntK / (nsplit ? nsplit : 1) : 0;
    int G, c;
    __device__ void init(int G_, int c_) { G = G_; c = c_; }
    __device__ __forceinline__ bool next(int i, Unit& u) const {
        const int L = i * G + c;
        const bool full = L < nwg;
        const int L2r = L - ((nwg + G - 1) / G) * G;
        const bool split = !full && nMs > 0 && L2r >= 0 && L2r < nMs * nN * nsplit;
        if (!full && !split) return false;
        const int L2 = split ? L2r : 0;
        int wgid = full ? L : 0; { constexpr int q = nwg / NXCD, r = nwg % NXCD; const int xcd = wgid % NXCD, off = wgid / NXCD; wgid = (xcd < r ? xcd * (q + 1) : r * (q + 1) + (xcd - r) * q) + off; }
        constexpr int nig = WGM * nN; const int gid = wgid / nig, fm = gid * WGM, gsz = (nM - fm) < WGM ? (nM - fm) : WGM;
        const int pm_f = fm + ((wgid % nig) % gsz), pn_f = (wgid % nig) / gsz;
        constexpr int nMs1 = nMs ? nMs : 1;
        const int part = L2 / (nN * nMs1);
        const int pm = full ? pm_f : nM + (L2 / nN) % nMs1, pn = full ? pn_f : L2 % nN, k0 = full ? 0 : part * ntS * 64, nt = full ? ntK : ntS, pt = full ? -1 : part;
        u.pm = pm; u.pn = pn; u.k0 = k0; u.nt = nt; u.part = pt;
        return true;
    }
};

struct EpiF32Scale {
    static constexpr bool PERM = false;
    float* C; int ldc; float* P; int prow0;
    __device__ __forceinline__ void operator()(const f32x4 (&acc)[2][2][4][2], const Unit& u, int wr, int wc, int fr, int fq) const {
        const int col0 = u.pn * BM + wc * 32 + 4 * fq;
        int row0 = u.pm * BM + wr * 64 + fr; float* C = this->C;
        if (u.part >= 0) { row0 -= prow0; C = P + (size_t)u.part * 1024 * 1024; }
#pragma unroll
        for (int ai = 0; ai < 2; ++ai)
#pragma unroll
            for (int m = 0; m < 4; ++m) { float* rowp = C + (size_t)(row0 + ai * HALF + m * 16) * ldc + col0;
#pragma unroll
                for (int bj = 0; bj < 2; ++bj)
#pragma unroll
                    for (int n = 0; n < 2; ++n) {
                        if (u.part >= 0) *(f32x4*)(rowp + bj * HALF + n * 16) = acc[ai][bj][m][n];
                        else { const f32x4 v = acc[ai][bj][m][n]; u32x2 wv; wv.x = pk2(v[0], v[1]); wv.y = pk2(v[2], v[3]);
                               *(u32x2*)((bf16_t*)this->C + (size_t)(row0 + ai * HALF + m * 16) * ldc + col0 + bj * HALF + n * 16) = wv; } } }
    }
};
struct EpiSwiGLU {
    static constexpr bool PERM = true;
    bf16_t* O;
    __device__ __forceinline__ void operator()(const f32x4 (&acc)[2][2][4][2], const Unit& u, int wr, int wc, int fr, int fq) const {
        const int row0 = u.pm * BM + wr * 64 + fr, col0 = u.pn * 128 + wc * 32 + 8 * fq;
#pragma unroll
        for (int ai = 0; ai < 2; ++ai)
#pragma unroll
            for (int m = 0; m < 4; ++m) { bf16_t* rowp = O + (size_t)(row0 + ai * HALF + m * 16) * DFF + col0;
                const f32x4 g0 = acc[ai][0][m][0], g1 = acc[ai][0][m][1], u0 = acc[ai][1][m][0], u1 = acc[ai][1][m][1];
                u32x4 w;
                w.x = pk2(silu_f(g0[0]) * u0[0], silu_f(g0[1]) * u0[1]); w.y = pk2(silu_f(g0[2]) * u0[2], silu_f(g0[3]) * u0[3]);
                w.z = pk2(silu_f(g1[0]) * u1[0], silu_f(g1[1]) * u1[1]); w.w = pk2(silu_f(g1[2]) * u1[2], silu_f(g1[3]) * u1[3]);
                *(u32x4*)rowp = w; }
    }
};
struct EpiProj {
    static constexpr bool PERM = true;
    bf16_t *PQKV, *Z, *BA;
    __device__ __forceinline__ void operator()(const f32x4 (&acc)[2][2][4][2], const Unit& u, int wr, int wc, int fr, int fq) const {
        bf16_t* base; int ld;
        if (u.pn < 16) { base = PQKV + u.pn * 256; ld = 4096; } else if (u.pn < 24) { base = Z + (u.pn - 16) * 256; ld = 2048; } else { base = BA; ld = 256; }
        const int row0 = u.pm * BM + wr * 64 + fr, col0 = wc * 32 + 8 * fq;
#pragma unroll
        for (int ai = 0; ai < 2; ++ai)
#pragma unroll
            for (int m = 0; m < 4; ++m) { bf16_t* rowp = base + (size_t)(row0 + ai * HALF + m * 16) * ld + col0;
#pragma unroll
                for (int bj = 0; bj < 2; ++bj) { const f32x4 v0 = acc[ai][bj][m][0], v1 = acc[ai][bj][m][1];
                    u32x4 w; w.x = pk2(v0[0], v0[1]); w.y = pk2(v0[2], v0[3]); w.z = pk2(v1[0], v1[1]); w.w = pk2(v1[2], v1[3]);
                    *(u32x4*)(rowp + bj * HALF) = w; } }
    }
};

template <class Epi, class GemmT, class Sched>
__device__ __forceinline__ void gemm_phase(LAS unsigned char* lds, const GemmT g, const Sched& S, const Epi& E, const int tid) {
    const int wid = __builtin_amdgcn_readfirstlane(tid >> 6), lane = tid & 63, wr = wid >> 2, wc = wid & 3, fr = lane & 15, fq = lane >> 4;
    unsigned voffA[2], voffB[2];
#pragma unroll
    for (int i = 0; i < 2; ++i) { int R, C; stage_rc(tid * 16 + i * 8192, R, C); const int Rb = Epi::PERM ? ((R & ~31) + perm32(R & 31)) : R;
        voffA[i] = (unsigned)(R * g.lda + C) * 2u; voffB[i] = (unsigned)(Rb * g.ldb + C) * 2u; }
    const size_t kstep = (size_t)(BK * 2);
    const size_t hstepA = (size_t)HALF * g.lda * 2, hstepB = (size_t)HALF * g.ldb * 2;
    const unsigned ldsw = (unsigned)wid * 1024u;
    const int aoff = lds_byte(wr * 64 + fr, fq * 8), boff = lds_byte(wc * 32 + fr, fq * 8);
#define PG8_SA(b, h) (((b) * 2 + (h)) * HTB)
#define PG8_SB(b, h) ((4 + (b) * 2 + (h)) * HTB)
#define PG8_STAGE(bufoff, gbase, voff) do { _Pragma("unroll") for (int _i = 0; _i < 2; ++_i) \
        __builtin_amdgcn_global_load_lds((const unsigned*)((const char*)(gbase) + (voff)[_i]), (LAS unsigned*)(lds + (bufoff) + ldsw + _i * 8192), 16, 0, 0); } while (0)
#define PG8_LDA(dst, b, h) do { _Pragma("unroll") for (int m = 0; m < 4; ++m) _Pragma("unroll") for (int k = 0; k < 2; ++k) dst[m][k] = *(const LAS bf16x8*)(lds + PG8_SA(b, h) + aoff + m * 2048 + k * 1024); } while (0)
#define PG8_LDB(dst, b, h) do { _Pragma("unroll") for (int n = 0; n < 2; ++n) _Pragma("unroll") for (int k = 0; k < 2; ++k) dst[n][k] = *(const LAS bf16x8*)(lds + PG8_SB(b, h) + boff + n * 2048 + k * 1024); } while (0)
#define PG8_MMA(ai, bj, At, Bt) do { __builtin_amdgcn_s_setprio(1); _Pragma("unroll") for (int m = 0; m < 4; ++m) _Pragma("unroll") for (int n = 0; n < 2; ++n) _Pragma("unroll") for (int k = 0; k < 2; ++k) \
        acc[ai][bj][m][n] = __builtin_amdgcn_mfma_f32_16x16x32_bf16(Bt[n][k], At[m][k], acc[ai][bj][m][n], 0, 0, 0); __builtin_amdgcn_s_setprio(0); } while (0)
#define PG8_WAIT_V(n) asm volatile("s_waitcnt vmcnt(" #n ")" ::: "memory")
#define PG8_WAIT_L(n) asm volatile("s_waitcnt lgkmcnt(" #n ")" ::: "memory")
#define PG8_BAR __builtin_amdgcn_s_barrier()
#define PG8_SCHED __builtin_amdgcn_sched_barrier(0)
    Unit cur, nxt; int ui = 0;
    if (!S.next(0, cur)) return;
    f32x4 acc[2][2][4][2];
#pragma unroll
    for (int a = 0; a < 2; ++a)
#pragma unroll
        for (int b = 0; b < 2; ++b)
#pragma unroll
            for (int m = 0; m < 4; ++m)
#pragma unroll
                for (int n = 0; n < 2; ++n) acc[a][b][m][n] = (f32x4){0.f, 0.f, 0.f, 0.f};
    bf16x8 At[4][2], B0[2][2], B1[2][2];
    const char* cA = (const char*)g.A + (size_t)cur.pm * 2 * hstepA + (size_t)(cur.pn * g.a_pn_off + cur.k0) * 2; const char* cB = (const char*)g.Bt + (size_t)cur.pn * 2 * hstepB + (size_t)cur.k0 * 2;
    PG8_STAGE(PG8_SB(0, 0), cB, voffB); PG8_STAGE(PG8_SA(0, 0), cA, voffA); PG8_STAGE(PG8_SB(0, 1), cB + hstepB, voffB); PG8_STAGE(PG8_SA(0, 1), cA + hstepA, voffA);
    if (wr == 1) PG8_BAR;
    PG8_WAIT_V(4); PG8_BAR;
    PG8_STAGE(PG8_SB(1, 0), cB + kstep, voffB); PG8_STAGE(PG8_SA(1, 0), cA + kstep, voffA); PG8_STAGE(PG8_SB(1, 1), cB + hstepB + kstep, voffB);
    PG8_WAIT_V(6); PG8_BAR;
    for (;;) {
        const bool has_next = S.next(ui + 1, nxt);
        const char* nA = has_next ? (const char*)g.A + (size_t)nxt.pm * 2 * hstepA + (size_t)(nxt.pn * g.a_pn_off + nxt.k0) * 2 : cA; const char* nB = has_next ? (const char*)g.Bt + (size_t)nxt.pn * 2 * hstepB + (size_t)nxt.k0 * 2 : cB;
        const int nt = cur.nt;
        for (int t = 0; t < nt; t += 2) {
            const bool last = (t == nt - 2);
            const char* a1 = cA + (size_t)(t + 1) * kstep;
            const char* a2 = last ? nA : cA + (size_t)(t + 2) * kstep; const char* b2 = last ? nB : cB + (size_t)(t + 2) * kstep;
            const char* a3 = a2 + kstep; const char* b3 = b2 + kstep;
            PG8_LDB(B0, 0, 0); PG8_SCHED; PG8_LDA(At, 0, 0); PG8_STAGE(PG8_SA(1, 1), a1 + hstepA, voffA);
            PG8_WAIT_L(8); PG8_BAR; PG8_WAIT_L(0); PG8_MMA(0, 0, At, B0); PG8_BAR; PG8_SCHED;
            PG8_LDB(B1, 0, 1); PG8_STAGE(PG8_SB(0, 0), b2, voffB);
            PG8_BAR; PG8_WAIT_L(0); PG8_MMA(0, 1, At, B1); PG8_BAR;
            PG8_LDA(At, 0, 1); PG8_STAGE(PG8_SA(0, 0), a2, voffA);
            PG8_BAR; PG8_WAIT_L(0); PG8_MMA(1, 0, At, B0); PG8_BAR; PG8_SCHED;
            PG8_STAGE(PG8_SB(0, 1), b2 + hstepB, voffB);
            PG8_WAIT_V(6); PG8_BAR; PG8_MMA(1, 1, At, B1); PG8_BAR;
            PG8_LDB(B0, 1, 0); PG8_SCHED; PG8_LDA(At, 1, 0); PG8_STAGE(PG8_SA(0, 1), a2 + hstepA, voffA);
            PG8_WAIT_L(8); PG8_BAR; PG8_WAIT_L(0); PG8_MMA(0, 0, At, B0); PG8_BAR; PG8_SCHED;
            PG8_LDB(B1, 1, 1); PG8_STAGE(PG8_SB(1, 0), b3, voffB);
            PG8_BAR; PG8_WAIT_L(0); PG8_MMA(0, 1, At, B1); PG8_BAR;
            PG8_LDA(At, 1, 1); PG8_STAGE(PG8_SA(1, 0), a3, voffA);
            PG8_BAR; PG8_WAIT_L(0); PG8_MMA(1, 0, At, B0); PG8_BAR; PG8_SCHED;
            PG8_STAGE(PG8_SB(1, 1), b3 + hstepB, voffB);
            PG8_WAIT_V(6); PG8_BAR; PG8_MMA(1, 1, At, B1); PG8_BAR;
        }
        E(acc, cur, wr, wc, fr, fq);
        if (!has_next) break;
#pragma unroll
        for (int a = 0; a < 2; ++a)
#pragma unroll
            for (int b = 0; b < 2; ++b)
#pragma unroll
                for (int m = 0; m < 4; ++m)
#pragma unroll
                    for (int n = 0; n < 2; ++n) acc[a][b][m][n] = (f32x4){0.f, 0.f, 0.f, 0.f};
        cur = nxt; cA = nA; cB = nB; ++ui;
    }
    PG8_WAIT_V(0);
    if (wr == 0) PG8_BAR;
    PG8_BAR;
#undef PG8_SA
#undef PG8_SB
#undef PG8_STAGE
#undef PG8_LDA
#undef PG8_LDB
#undef PG8_MMA
#undef PG8_WAIT_V
#undef PG8_WAIT_L
#undef PG8_BAR
#undef PG8_SCHED
}
}

struct Frame {
    LAS unsigned char* lds;
    int tid, lane, wave, gw, NGW, G, blk;
    const float* in[19];
    float* out; unsigned char* ws;
};
#define WSP(type, off) ((type*)(F.ws + (off)))

__device__ __forceinline__ void transpose_item(const float* W, int N, int k0, int nsrc0, bf16_t* WT, int K, int ndst0, LAS float* scr, int lane) {
    float wv[32];
#pragma unroll
    for (int i = 0; i < 32; ++i) wv[i] = __builtin_nontemporal_load(W + (size_t)(k0 + 2 * i + (lane >> 5)) * N + nsrc0 + (lane & 31));
#pragma unroll
    for (int i = 0; i < 32; ++i) scr[(2 * i + (lane >> 5)) * 33 + (lane & 31)] = wv[i];
    LDS_WAIT();
    const int c = lane & 7;
#pragma unroll
    for (int j = 0; j < 4; ++j) { const int n = (lane >> 3) + 8 * j; const LAS float* s = scr + (8 * c) * 33 + n;
        u32x4 o; o.x = pk2(s[0 * 33], s[1 * 33]); o.y = pk2(s[2 * 33], s[3 * 33]); o.z = pk2(s[4 * 33], s[5 * 33]); o.w = pk2(s[6 * 33], s[7 * 33]);
        *(u32x4*)(WT + (size_t)(ndst0 + n) * K + k0 + 8 * c) = o; }
    LDS_WAIT();
}

__device__ __forceinline__ void front_phase(Frame& F) {
    LAS float* rs = (LAS float*)(F.lds + 8 * 8448);
    const float* xp = F.in[0]; const float* xs = F.in[1]; const float* spool = F.in[2]; const float* gain = F.in[5];
    bf16_t* DB = WSP(bf16_t, OFF_DB);
    const int tid = F.tid, c = 2 * tid, gi = tid >> 7, win = 2 << gi;
    const f32x2 gn = *(const f32x2*)(gain + c);
    const float inv_win = 1.0f / (float)win;
    for (int item = F.blk; item < 512 + 128; item += F.G) {
        __syncthreads();
        if (item < 512) {
            const int b = item >> 6, l0 = (item & 63) * 32;
            const float* xb = xp + (size_t)b * SEQ * D;
            { float sq[6];
#pragma unroll
              for (int i = 0; i < 6; ++i) { const int r = F.wave + 8 * i, l = l0 - 15 + r; const bool ok = r < 47 && l >= 0;
                  const f32x4* xr = (const f32x4*)(xb + (size_t)(ok ? l : l0) * D) + F.lane; float s = 0.f;
#pragma unroll
                  for (int j = 0; j < 4; ++j) { const f32x4 q = xr[64 * j]; s += q.x * q.x + q.y * q.y + q.z * q.z + q.w * q.w; }
                  sq[i] = ok ? s : 0.f; }
#pragma unroll
              for (int i = 0; i < 6; ++i) { const int r = F.wave + 8 * i; const float v = rsqrtf(wave_sum(sq[i]) * (1.0f / D) + EPS);
                  if (F.lane == 0 && r < 47) rs[r] = v; } }
            __syncthreads();
            f32x2 S = {0.f, 0.f};
#pragma unroll
            for (int d = 1; d < 16; ++d) { const int j = l0 - d; const bool ok = d < win && j >= 0;
                const f32x2 xv = *(const f32x2*)(xb + (size_t)(ok ? j : l0) * D + c); const float r = ok ? rs[15 - d] : 0.f; S.x += xv.x * r * gn.x; S.y += xv.y * r * gn.y; }
#pragma unroll 16
            for (int l = l0; l < l0 + 32; ++l) {
                const f32x2 xv = *(const f32x2*)(xb + (size_t)l * D + c); const float r = rs[l - l0 + 15];
                const f32x2 hv = {xv.x * r * gn.x, xv.y * r * gn.y};
                S.x += hv.x; S.y += hv.y;
                const float ic = (l + 1 < win) ? 1.0f / (float)(l + 1) : inv_win;
                *(unsigned*)(DB + (size_t)(b * SEQ + l) * D + c) = pk2(S.x * ic - hv.x, S.y * ic - hv.y);
                const int jo = l - win + 1;
                if (jo >= 0) { const f32x2 xo = *(const f32x2*)(xb + (size_t)jo * D + c); const float ro = rs[jo - l0 + 15]; S.x -= xo.x * ro * gn.x; S.y -= xo.y * ro * gn.y; }
                if (l >= SEQ - 15) *(f32x2*)(F.out + O_POOLP + (size_t)(b * 15 + (l - (SEQ - 15))) * D + c) = hv;
            }
        } else {
            const int s0 = item - 512;
            { const int r = F.wave; const f32x4* xr = (const f32x4*)(xs + (size_t)(s0 * 8 + r) * D) + F.lane; float s = 0.f;
#pragma unroll
                for (int j = 0; j < 4; ++j) { const f32x4 q = xr[64 * j]; s += q.x * q.x + q.y * q.y + q.z * q.z + q.w * q.w; }
                const float v = rsqrtf(wave_sum(s) * (1.0f / D) + EPS);
                if (F.lane == 0) rs[r] = v; }
            __syncthreads();
            { const int si = 0;
                const int s = s0 + si; const float* buf = spool + (size_t)s * 15 * D; const float* xq = xs + (size_t)s * 8 * D;
                float* po = F.out + O_POOLS + (size_t)s * 15 * D;
                f32x2 S = {0.f, 0.f};
#pragma unroll
                for (int d = 1; d < 16; ++d) { const bool ok = d < win; const f32x2 bv = *(const f32x2*)(buf + (size_t)(ok ? 15 - d : 14) * D + c); if (ok) { S.x += bv.x; S.y += bv.y; } }
                for (int i = 0; i < 7; ++i) *(f32x2*)(po + (size_t)i * D + c) = *(const f32x2*)(buf + (size_t)(8 + i) * D + c);
#pragma unroll
                for (int l = 0; l < 8; ++l) {
                    const f32x2 xv = *(const f32x2*)(xq + (size_t)l * D + c); const float r = rs[si * 8 + l];
                    const f32x2 hv = {xv.x * r * gn.x, xv.y * r * gn.y};
                    S.x += hv.x; S.y += hv.y;
                    *(unsigned*)(DB + (size_t)(TP + s * 8 + l) * D + c) = pk2(S.x * inv_win - hv.x, S.y * inv_win - hv.y);
                    const int jo = l - win + 1;
                    if (jo >= 0) { const f32x2 xo = *(const f32x2*)(xq + (size_t)jo * D + c); const float ro = rs[si * 8 + jo]; S.x -= xo.x * ro * gn.x; S.y -= xo.y * ro * gn.y; }
                    else { const f32x2 bv = *(const f32x2*)(buf + (size_t)(jo + 15) * D + c); S.x -= bv.x; S.y -= bv.y; }
                    *(f32x2*)(po + (size_t)(7 + l) * D + c) = hv;
                }
            }
        }
    }
}

__device__ __forceinline__ void transpose_items(Frame& F, bool late, int gw0, int ngw) {
    LAS float* scr = (LAS float*)(F.lds + F.wave * 8448);
    constexpr int I_P = 4 * 4 * 8, I_FI = 16 * 176, I_FO = 44 * 32, I_GI = 16 * 193, I_GO = 32 * 32;
    const int nitems = late ? I_FI + I_FO + I_GO : I_P + I_FI + I_FO + I_GI;
    const int ly = late ? 1 : 0;
    for (int it = gw0; it < nitems; it += ngw) {
        int r = it;
        if (!late) {
            if (r < I_P) { const int g = r >> 5, q = r & 31, kb = q >> 3, nb = q & 7;
                transpose_item(F.in[9] + (size_t)g * 65536, 256, 64 * kb, 32 * nb, WSP(bf16_t, OFF_WP), 256, g * 256 + 32 * nb, scr, F.lane); continue; }
            r -= I_P;
        }
        if (r < I_FI) { const int kb = r / 176, nb = r % 176;
            const int nd = 32 * nb, pn = nd >> 8, rr = nd & 255, ns = rr < 128 ? 128 * pn + rr : DFF + 128 * pn + (rr - 128);
            transpose_item(F.in[17] + (size_t)ly * 1024 * NFI, NFI, 64 * kb, ns, WSP(bf16_t, OFF_WFI) + (size_t)ly * NFI * 1024, 1024, nd, scr, F.lane); continue; }
        r -= I_FI;
        if (r < I_FO) { const int kb = r >> 5, nb = r & 31;
            transpose_item(F.in[18] + (size_t)ly * DFF * 1024, 1024, 64 * kb, 32 * nb, WSP(bf16_t, OFF_WFO) + (size_t)ly * 1024 * DFF, DFF, 32 * nb, scr, F.lane); continue; }
        r -= I_FO;
        if (!late) { const int kb = r / 193, nb = r % 193;
            transpose_item(F.in[11], NGI, 64 * kb, 32 * nb, WSP(bf16_t, OFF_WGI), 1024, 32 * nb, scr, F.lane); }
        else { const int kb = r >> 5, nb = r & 31;
            transpose_item(F.in[16], 1024, 64 * kb, 32 * nb, WSP(bf16_t, OFF_WGO), 2048, 32 * nb, scr, F.lane); }
    }
}
__device__ __forceinline__ void prep_phase(Frame& F) {
    transpose_items(F, false, F.gw, F.NGW);
    { u32x4* z = (u32x4*)(WSP(bf16_t, OFF_WGI) + (size_t)NGI * 1024); const int n16 = (NGIP - NGI) * 1024 * 2 / 16;
      unsigned z0 = 0u; asm volatile("" : "+v"(z0));
      for (int i = F.blk * 512 + F.tid; i < n16; i += F.G * 512) z[i] = (u32x4){z0, z0, z0, z0}; }
    front_phase(F);
}

struct RowRaw { u32x2 m[4]; u32x2 xb[4]; f32x4 xf[4]; };
template <int nparts>
__device__ __forceinline__ void row_phase(Frame& F, const float* xin_p, const float* xin_s, const float* gpost, const float* gpre, const float* mscale, bool out_f32) {
    const bf16_t* MRb = WSP(bf16_t, OFF_MR); bf16_t* H = WSP(bf16_t, OFF_H); float* XA = F.out + O_Y; bf16_t* XB = WSP(bf16_t, OFF_XB);
    f32x4 gp[4], gq[4];
#pragma unroll
    for (int j = 0; j < 4; ++j) { gp[j] = ((const f32x4*)gpost)[F.lane + 64 * j]; gq[j] = gpre ? ((const f32x4*)gpre)[F.lane + 64 * j] : (f32x4){0.f, 0.f, 0.f, 0.f}; }
    auto issue = [&](int row, RowRaw& r) {
        const bool part = nparts > 0 && row >= TP;
        if (!part) {
#pragma unroll
            for (int j = 0; j < 4; ++j) r.m[j] = __builtin_nontemporal_load((const u32x2*)(MRb + (size_t)row * D) + F.lane + 64 * j); }
        if (xin_p) { const f32x4* xr = (const f32x4*)(row < TP ? xin_p + (size_t)row * D : xin_s + (size_t)(row - TP) * D) + F.lane;
#pragma unroll
            for (int j = 0; j < 4; ++j) r.xf[j] = __builtin_nontemporal_load(xr + 64 * j); }
        else {
#pragma unroll
            for (int j = 0; j < 4; ++j) r.xb[j] = __builtin_nontemporal_load((const u32x2*)(XB + (size_t)row * D) + F.lane + 64 * j); }
    };
    RowRaw cur, nxt;
    int row = F.gw;
    if (row < T) issue(row, cur);
    for (; row < T; row += F.NGW) {
        const int rn = row + F.NGW;
        if (rn < T) issue(rn, nxt);
        f32x4 m[4], x[4]; float s = 0.f;
#pragma unroll
        for (int j = 0; j < 4; ++j) {
            if (nparts > 0 && row >= TP) { const f32x4* pr = (const f32x4*)(WSP(float, OFF_Z) + (size_t)(row - TP) * D) + F.lane + 64 * j;
                f32x4 pv[nparts > 0 ? nparts : 1];
#pragma unroll
                for (int p = 0; p < nparts; ++p) pv[p] = pr[(size_t)p * (1024 * 1024 / 4)];
                f32x4 a = pv[0];
#pragma unroll
                for (int p = 1; p < nparts; ++p) a = a + pv[p];
                m[j] = a; }
            else m[j] = (f32x4){bflo(cur.m[j].x), bfhi(cur.m[j].x), bflo(cur.m[j].y), bfhi(cur.m[j].y)};
            if (mscale) m[j] = m[j] * ((const f32x4*)mscale)[F.lane + 64 * j];
            if (xin_p) x[j] = cur.xf[j]; else x[j] = (f32x4){bflo(cur.xb[j].x), bfhi(cur.xb[j].x), bflo(cur.xb[j].y), bfhi(cur.xb[j].y)};
            s += m[j].x * m[j].x + m[j].y * m[j].y + m[j].z * m[j].z + m[j].w * m[j].w; }
        const float r1 = rsqrtf(wave_sum(s) * (1.0f / D) + EPS); float s2 = 0.f;
#pragma unroll
        for (int j = 0; j < 4; ++j) { x[j] = x[j] + m[j] * r1 * gp[j]; s2 += x[j].x * x[j].x + x[j].y * x[j].y + x[j].z * x[j].z + x[j].w * x[j].w; }
        if (out_f32) { f32x4* xo = (f32x4*)(XA + (size_t)row * D) + F.lane;
#pragma unroll
            for (int j = 0; j < 4; ++j) __builtin_nontemporal_store(x[j], xo + 64 * j); }
        else { u32x2* xo = (u32x2*)(XB + (size_t)row * D) + F.lane;
#pragma unroll
            for (int j = 0; j < 4; ++j) { u32x2 w; w.x = pk2(x[j].x, x[j].y); w.y = pk2(x[j].z, x[j].w); xo[64 * j] = w; } }
        if (gpre) {
            const float r2 = rsqrtf(wave_sum(s2) * (1.0f / D) + EPS);
            u32x2* ho = (u32x2*)(H + (size_t)row * D) + F.lane;
#pragma unroll
            for (int j = 0; j < 4; ++j) { const f32x4 h = x[j] * r2 * gq[j]; u32x2 w; w.x = pk2(h.x, h.y); w.y = pk2(h.z, h.w); ho[64 * j] = w; }
        }
        cur = nxt;
    }
}

template <int NROWS>
__device__ __forceinline__ void conv_rows(const bf16_t* PQKV, int t0, f32x4 (&u)[3][2], const f32x4 (&w)[4][2], int slab, int ch0, bf16_t* dst, int dld, float* cout, int l_first_out) {
    u32x4 rawv[NROWS];
#pragma unroll
    for (int i = 0; i < NROWS; ++i) rawv[i] = __builtin_nontemporal_load((const u32x4*)(PQKV + (size_t)(t0 + i) * 4096 + ch0));
#pragma unroll
    for (int i = 0; i < NROWS; ++i) {
        const u32x4 raw = rawv[i];
        f32x4 c0 = {bflo(raw.x), bfhi(raw.x), bflo(raw.y), bfhi(raw.y)}, c1 = {bflo(raw.z), bfhi(raw.z), bflo(raw.w), bfhi(raw.w)};
        f32x4 o0 = w[0][0] * u[2][0] + w[1][0] * u[1][0] + w[2][0] * u[0][0] + w[3][0] * c0;
        f32x4 o1 = w[0][1] * u[2][1] + w[1][1] * u[1][1] + w[2][1] * u[0][1] + w[3][1] * c1;
#pragma unroll
        for (int e = 0; e < 4; ++e) { o0[e] = silu_f(o0[e]); o1[e] = silu_f(o1[e]); }
        if (slab < 4) {
            float ss = o0.x * o0.x + o0.y * o0.y + o0.z * o0.z + o0.w * o0.w + o1.x * o1.x + o1.y * o1.y + o1.z * o1.z + o1.w * o1.w;
            ss += __shfl_xor(ss, 1); ss += __shfl_xor(ss, 2); ss += __shfl_xor(ss, 4); ss += __shfl_xor(ss, 8);
            float sc = rsqrtf(ss + EPS); if (slab < 2) sc *= 0.08838834764831845f;
            o0 = o0 * sc; o1 = o1 * sc;
        }
        u32x4 pk; pk.x = pk2(o0.x, o0.y); pk.y = pk2(o0.z, o0.w); pk.z = pk2(o1.x, o1.y); pk.w = pk2(o1.z, o1.w);
        *(u32x4*)(dst + (size_t)(t0 + i) * dld) = pk;
        if (cout && i >= l_first_out) { float* co = cout + (size_t)(i - l_first_out) * 4096; *(f32x4*)co = c0; *(f32x4*)(co + 4) = c1; }
        u[2][0] = u[1][0]; u[2][1] = u[1][1]; u[1][0] = u[0][0]; u[1][1] = u[0][1]; u[0][0] = c0; u[0][1] = c1;
    }
}
__device__ __forceinline__ void conv_phase(Frame& F) {
    const bf16_t* PQKV = WSP(bf16_t, OFF_BIG); const float* cw = F.in[12]; const float* cst = F.in[3];
    const bool slab_const = (F.NGW & 7) == 0;
    f32x4 wc[4][2];
    { const int ch0c = (F.gw & 7) * 512 + F.lane * 8;
#pragma unroll
      for (int tp = 0; tp < 4; ++tp) { wc[tp][0] = *(const f32x4*)(cw + tp * 4096 + ch0c); wc[tp][1] = *(const f32x4*)(cw + tp * 4096 + ch0c + 4); } }
    for (int item = F.gw; item < (1024 + 128) * 8; item += F.NGW) {
        const int rt = item >> 3, slab = item & 7, ch0 = slab * 512 + F.lane * 8;
        f32x4 w[4][2];
#pragma unroll
        for (int tp = 0; tp < 4; ++tp) { w[tp][0] = wc[tp][0]; w[tp][1] = wc[tp][1]; }
        if (!slab_const) {
#pragma unroll
            for (int tp = 0; tp < 4; ++tp) { w[tp][0] = *(const f32x4*)(cw + tp * 4096 + ch0); w[tp][1] = *(const f32x4*)(cw + tp * 4096 + ch0 + 4); } }
        bf16_t* dst; int dld;
        if (slab < 2) { dst = WSP(bf16_t, OFF_QB) + ch0; dld = 1024; } else if (slab < 4) { dst = WSP(bf16_t, OFF_KB) + (ch0 - 1024); dld = 1024; } else { dst = WSP(bf16_t, OFF_VB) + (ch0 - 2048); dld = 2048; }
        f32x4 u[3][2];
        if (rt < 1024) {
            const int b = rt >> 7, l0 = (rt & 127) * 16, t0 = b * SEQ + l0;
#pragma unroll
            for (int p = 0; p < 3; ++p) {
                if (l0 > 0) { const u32x4 raw = *(const u32x4*)(PQKV + (size_t)(t0 - 1 - p) * 4096 + ch0);
                    u[p][0] = (f32x4){bflo(raw.x), bfhi(raw.x), bflo(raw.y), bfhi(raw.y)}; u[p][1] = (f32x4){bflo(raw.z), bfhi(raw.z), bflo(raw.w), bfhi(raw.w)}; }
                else { u[p][0] = (f32x4){0.f, 0.f, 0.f, 0.f}; u[p][1] = (f32x4){0.f, 0.f, 0.f, 0.f}; } }
            const bool tail = (l0 == SEQ - 16);
            conv_rows<16>(PQKV, t0, u, w, slab, ch0, dst, dld, tail ? F.out + O_CONVP + (size_t)b * 3 * 4096 + ch0 : nullptr, 13);
        } else {
            {
                const int s = rt - 1024, t0 = TP + s * 8;
#pragma unroll
                for (int p = 0; p < 3; ++p) { const float* sp = cst + (size_t)(s * 3 + (2 - p)) * 4096 + ch0; u[p][0] = *(const f32x4*)sp; u[p][1] = *(const f32x4*)(sp + 4); }
                conv_rows<8>(PQKV, t0, u, w, slab, ch0, dst, dld, F.out + O_CONVS + (size_t)s * 3 * 4096 + ch0, 5);
            }
        }
    }
}

template <int I> __device__ __forceinline__ void fs_row(float (&X)[64], const LAS float* Am, bf16_t* tinv, int lane, int nvalid, int nst) {
    float a = (lane == I) ? 1.f : 0.f;
    if (I < nvalid) {
        float a1 = 0.f, a2 = 0.f, a3 = 0.f;
#pragma unroll
        for (int j4 = 0; j4 < (I + 3) / 4; ++j4) { const f32x4 av = *(const LAS f32x4*)(Am + I * 68 + 4 * j4);
            if (4 * j4 + 0 < I) a -= av[0] * X[4 * j4 + 0];
            if (4 * j4 + 1 < I) a1 -= av[1] * X[4 * j4 + 1];
            if (4 * j4 + 2 < I) a2 -= av[2] * X[4 * j4 + 2];
            if (4 * j4 + 3 < I) a3 -= av[3] * X[4 * j4 + 3]; }
        a = (a + a1) + (a2 + a3);
    }
    X[I] = a;
    if (I < nst) tinv[I * 64 + lane] = (bf16_t)(pk2(a, 0.f) & 0xffffu);
    asm volatile("" ::: "memory");
}
__device__ __forceinline__ void gdn_pre_phase(Frame& F) {
    LAS float* Am = (LAS float*)(F.lds + F.wave * 17920);
    LAS float* gcs = Am + 64 * 68; LAS float* bts = gcs + 64;
    const bf16_t* QB = WSP(bf16_t, OFF_QB); const bf16_t* KB = WSP(bf16_t, OFF_KB); const bf16_t* BA = WSP(bf16_t, OFF_BA);
    bf16_t* TQ = WSP(bf16_t, OFF_BIG); float* GC = WSP(float, OFF_GC); float* BETA = WSP(float, OFF_BETA);
    for (int it = F.gw; it < 6144; it += F.NGW) {
        int lane = F.lane; asm volatile("" : "+v"(lane));
        const int c16 = lane & 15, q = lane >> 4;
        int t0, nvalid; const int h = it & 15, kh = h >> 1;
        if (it < 4096) { const int b = it >> 9, n = (it >> 4) & 31; t0 = b * SEQ + n * 64; nvalid = 64; } else { const int s = (it - 4096) >> 4; t0 = TP + s * 8; nvalid = 8; }
        const int nti = nvalid > 16 ? 4 : 1, nst = nvalid > 16 ? 64 : 16;
        float beta = 0.f, g = 0.f;
        { const int lr = lane < nvalid ? lane : 0;
            const float bb = bf2f(BA[(size_t)(t0 + lr) * 256 + h]), aa = bf2f(BA[(size_t)(t0 + lr) * 256 + 16 + h]);
            const float xx = aa + F.in[14][h]; const float sp = xx > 20.f ? xx : log1pf(__expf(xx));
            if (lane < nvalid) { beta = 1.0f / (1.0f + __expf(-bb)); g = -__expf(F.in[13][h]) * sp; }
        }
        float gc = g;
#pragma unroll
        for (int o = 1; o < 64; o <<= 1) { const float tv = __shfl_up(gc, o); if (lane >= o) gc += tv; }
        GC[(size_t)it * 64 + lane] = gc; BETA[(size_t)it * 64 + lane] = beta; gcs[lane] = gc; bts[lane] = beta;
        f32x4 kka[10], qka[10];
#pragma unroll
        for (int x = 0; x < 10; ++x) { kka[x] = (f32x4){0.f, 0.f, 0.f, 0.f}; qka[x] = (f32x4){0.f, 0.f, 0.f, 0.f}; }
#pragma unroll
        for (int ks = 0; ks < 4; ++ks) {
            bf16x8 Kf[4], Qf[4];
#pragma unroll
            for (int rt = 0; rt < 4; ++rt) { if (rt >= nti) continue; const int row = 16 * rt + c16; const bool ok = row < nvalid;
                const int rowc = ok ? row : 0;
                const bf16_t* kp = KB + (size_t)(t0 + rowc) * 1024 + kh * 128 + 8 * q + 32 * ks; const bf16_t* qp = QB + (size_t)(t0 + rowc) * 1024 + kh * 128 + 8 * q + 32 * ks;
                Kf[rt] = *(const bf16x8*)kp; Qf[rt] = *(const bf16x8*)qp;
                if (!ok) { Kf[rt] = (bf16x8){0, 0, 0, 0, 0, 0, 0, 0}; Qf[rt] = (bf16x8){0, 0, 0, 0, 0, 0, 0, 0}; } }
#pragma unroll
            for (int ti = 0; ti < 4; ++ti)
#pragma unroll
                for (int tj = 0; tj <= ti; ++tj) { if (ti >= nti) continue; const int x = ti * (ti + 1) / 2 + tj;
                    kka[x] = __builtin_amdgcn_mfma_f32_16x16x32_bf16(Kf[ti], Kf[tj], kka[x], 0, 0, 0); qka[x] = __builtin_amdgcn_mfma_f32_16x16x32_bf16(Qf[ti], Kf[tj], qka[x], 0, 0, 0); }
            asm volatile("" ::: "memory");
        }
        LDS_WAIT();
        bf16_t* tinv = TQ + (size_t)it * 8192; bf16_t* qkd = tinv + 4096;
#pragma unroll
        for (int ti = 0; ti < 4; ++ti)
#pragma unroll
            for (int tj = 0; tj < 4; ++tj) {
                if (ti >= nti) continue;
                if (tj <= ti) {
                    const int x = ti * (ti + 1) / 2 + tj;
                    const int jj = 16 * tj + c16; const float gj = gcs[jj];
#pragma unroll
                    for (int j = 0; j < 4; ++j) { const int i = 16 * ti + 4 * q + j; const float gi = gcs[i], bi = bts[i];
                        const float dec = (i >= jj) ? __expf(gi - gj) : 0.f;
                        Am[i * 68 + jj] = (i > jj) ? bi * kka[x][j] * dec : 0.f;
                        qkd[i * 64 + jj] = (bf16_t)(pk2((i >= jj) ? qka[x][j] * dec : 0.f, 0.f) & 0xffffu); }
                } else {
#pragma unroll
                    for (int j = 0; j < 4; ++j) qkd[(16 * ti + 4 * q + j) * 64 + 16 * tj + c16] = 0;
                }
                asm volatile("" ::: "memory");
            }
        LDS_WAIT();
        float X[64];
        const int lo = lane;
#define FS1(i) fs_row<i>(X, Am, tinv, lo, nvalid, nst);
#define FS4(i) FS1(i) FS1(i + 1) FS1(i + 2) FS1(i + 3)
#define FS16(i) FS4(i) FS4(i + 4) FS4(i + 8) FS4(i + 12)
        FS16(0) FS16(16) FS16(32) FS16(48)
#undef FS16
#undef FS4
#undef FS1
        LDS_WAIT();
    }
}

__device__ __forceinline__ void gdn_scan_item(Frame& F, int t0_first, int nchunks, int nvalid, int item0, int item_stride, int h, const float* s_in, float* s_out) {
    LAS bf16_t* KT = (LAS bf16_t*)F.lds;
    LAS bf16_t* ST = KT + 128 * 72;
    LAS bf16_t* RT = ST + 128 * 136;
    LAS bf16_t* VN = RT + 128 * 72;
    LAS bf16_t* VS = VN + 128 * 72;
    LAS float* ssx = (LAS float*)(VS + 128 * 72);
    const bf16_t* QB = WSP(bf16_t, OFF_QB); const bf16_t* KB = WSP(bf16_t, OFF_KB); const bf16_t* VB = WSP(bf16_t, OFF_VB); const bf16_t* Z = WSP(bf16_t, OFF_Z);
    const bf16_t* TQ = WSP(bf16_t, OFF_BIG); const float* GC = WSP(float, OFF_GC); const float* BETA = WSP(float, OFF_BETA);
    bf16_t* ON = WSP(bf16_t, OFF_ON);
    int lane = F.lane; asm volatile("" : "+v"(lane));
    const int w = F.wave, c16 = lane & 15, q = lane >> 4, ct = w >> 1, vh = w & 1, kh = h >> 1;
    f32x4 S[8];
#pragma unroll
    for (int vt = 0; vt < 8; ++vt) S[vt] = (f32x4){0.f, 0.f, 0.f, 0.f};
    if (s_in) {
#pragma unroll
        for (int vt = 0; vt < 8; ++vt)
#pragma unroll
            for (int j = 0; j < 4; ++j) S[vt][j] = s_in[(size_t)(16 * w + 4 * q + j) * 128 + 16 * vt + c16];
    }
#pragma unroll
    for (int vt = 0; vt < 8; ++vt) {
        u32x2 pk; pk.x = pk2(S[vt][0], S[vt][1]); pk.y = pk2(S[vt][2], S[vt][3]);
        *(LAS u32x2*)(ST + (16 * vt + c16) * 136 + 16 * w + 4 * q) = pk;
    }
    float on_g[4];
#pragma unroll
    for (int vt = 0; vt < 4; ++vt) on_g[vt] = F.in[15][16 * (4 * vh + vt) + c16];
    const int rowA = 16 * ct + c16; const bool rvalid = rowA < nvalid;
    const int i0 = 16 * ct + 4 * q;
    const unsigned offKQ = rowA * 1024 + 8 * q, offKT = lane * 1024 + 16 * w, offTQ = rowA * 64 + 8 * q, offV = i0 * 2048 + 64 * vh + c16;
    for (int n = 0; n < nchunks; ++n) {
        const int t0 = t0_first + n * 64; const size_t item = (size_t)item0 + (size_t)n * item_stride;
        bf16x8 Kf[4], Qf[4], Tf[2], QKf[2];
        const bf16_t* kb_ = KB + (size_t)t0 * 1024 + kh * 128; const bf16_t* qb_ = QB + (size_t)t0 * 1024 + kh * 128; const bf16_t* tq_ = TQ + item * 8192;
        const bf16_t* vb_ = VB + (size_t)t0 * 2048 + h * 128; const bf16_t* zb_ = Z + (size_t)t0 * 2048 + h * 128;
        u32x4 k0, k1;
        { const u32x4* kp = (const u32x4*)(kb_ + offKT); k0 = kp[0]; k1 = kp[1]; }
#pragma unroll
        for (int ks = 0; ks < 4; ++ks) { Kf[ks] = *(const bf16x8*)(kb_ + (offKQ + 32u * ks)); Qf[ks] = *(const bf16x8*)(qb_ + (offKQ + 32u * ks)); }
        const f32x4 gc4 = *(const f32x4*)(GC + item * 64 + (unsigned)i0), beta4 = *(const f32x4*)(BETA + item * 64 + (unsigned)i0);
        const float gcl = GC[item * 64 + 63];
        typedef unsigned short us2 __attribute__((ext_vector_type(2)));
        us2 vvr[4][2], zzr[4][2];
#pragma unroll
        for (int vt = 0; vt < 4; ++vt)
#pragma unroll
            for (int j2 = 0; j2 < 2; ++j2) { us2 x_; x_.x = vb_[offV + (unsigned)((2 * j2) * 2048 + vt * 16)]; x_.y = vb_[offV + (unsigned)((2 * j2 + 1) * 2048 + vt * 16)]; vvr[vt][j2] = x_; }
        float egc[4], edl[4];
#pragma unroll
        for (int j = 0; j < 4; ++j) { egc[j] = __expf(gc4[j]); edl[j] = __expf(gcl - gc4[j]); }
        const float egl = __expf(gcl);
        LBAR();
        { LAS bf16_t* kt = KT + (16 * w) * 72 + lane;
          kt[0 * 72] = (bf16_t)(k0.x & 0xffff); kt[1 * 72] = (bf16_t)(k0.x >> 16); kt[2 * 72] = (bf16_t)(k0.y & 0xffff); kt[3 * 72] = (bf16_t)(k0.y >> 16);
          kt[4 * 72] = (bf16_t)(k0.z & 0xffff); kt[5 * 72] = (bf16_t)(k0.z >> 16); kt[6 * 72] = (bf16_t)(k0.w & 0xffff); kt[7 * 72] = (bf16_t)(k0.w >> 16);
          kt[8 * 72] = (bf16_t)(k1.x & 0xffff); kt[9 * 72] = (bf16_t)(k1.x >> 16); kt[10 * 72] = (bf16_t)(k1.y & 0xffff); kt[11 * 72] = (bf16_t)(k1.y >> 16);
          kt[12 * 72] = (bf16_t)(k1.z & 0xffff); kt[13 * 72] = (bf16_t)(k1.z >> 16); kt[14 * 72] = (bf16_t)(k1.w & 0xffff); kt[15 * 72] = (bf16_t)(k1.w >> 16); }
#pragma unroll
        for (int ks = 0; ks < 2; ++ks) { Tf[ks] = *(const bf16x8*)(tq_ + (offTQ + 32u * ks)); QKf[ks] = *(const bf16x8*)(tq_ + (offTQ + 4096u + 32u * ks)); }
        f32x4 ksa[4], qsa[4];
#pragma unroll
        for (int vt = 0; vt < 4; ++vt) { ksa[vt] = (f32x4){0.f, 0.f, 0.f, 0.f}; qsa[vt] = (f32x4){0.f, 0.f, 0.f, 0.f};
#pragma unroll
            for (int ks = 0; ks < 4; ++ks) { const bf16x8 Sf = *(const LAS bf16x8*)(ST + (16 * (4 * vh + vt) + c16) * 136 + 32 * ks + 8 * q);
                ksa[vt] = __builtin_amdgcn_mfma_f32_16x16x32_bf16(Kf[ks], Sf, ksa[vt], 0, 0, 0); qsa[vt] = __builtin_amdgcn_mfma_f32_16x16x32_bf16(Qf[ks], Sf, qsa[vt], 0, 0, 0); } }
#pragma unroll
        for (int vt = 0; vt < 4; ++vt) { float r[4];
#pragma unroll
            for (int j = 0; j < 4; ++j) r[j] = beta4[j] * (bf2f(vvr[vt][j >> 1][j & 1]) - egc[j] * ksa[vt][j]);
            u32x2 pk; pk.x = pk2(r[0], r[1]); pk.y = pk2(r[2], r[3]);
            *(LAS u32x2*)(RT + (16 * (4 * vh + vt) + c16) * 72 + i0) = pk; }
        LBAR();
#pragma unroll
        for (int vt = 0; vt < 4; ++vt)
#pragma unroll
            for (int j2 = 0; j2 < 2; ++j2) { us2 x_; x_.x = zb_[offV + (unsigned)((2 * j2) * 2048 + vt * 16)]; x_.y = zb_[offV + (unsigned)((2 * j2 + 1) * 2048 + vt * 16)]; zzr[vt][j2] = x_; }
        f32x4 vn[4];
#pragma unroll
        for (int vt = 0; vt < 4; ++vt) { vn[vt] = (f32x4){0.f, 0.f, 0.f, 0.f};
#pragma unroll
            for (int ks = 0; ks < 2; ++ks) { const bf16x8 Rf = *(const LAS bf16x8*)(RT + (16 * (4 * vh + vt) + c16) * 72 + 32 * ks + 8 * q);
                vn[vt] = __builtin_amdgcn_mfma_f32_16x16x32_bf16(Tf[ks], Rf, vn[vt], 0, 0, 0); }
            u32x2 pa, pb; pa.x = pk2(vn[vt][0], vn[vt][1]); pa.y = pk2(vn[vt][2], vn[vt][3]);
            pb.x = pk2(vn[vt][0] * edl[0], vn[vt][1] * edl[1]); pb.y = pk2(vn[vt][2] * edl[2], vn[vt][3] * edl[3]);
            *(LAS u32x2*)(VN + (16 * (4 * vh + vt) + c16) * 72 + i0) = pa; *(LAS u32x2*)(VS + (16 * (4 * vh + vt) + c16) * 72 + i0) = pb; }
        LBAR();
        float ss[4] = {0.f, 0.f, 0.f, 0.f};
#pragma unroll
        for (int vt = 0; vt < 4; ++vt) {
#pragma unroll
            for (int j = 0; j < 4; ++j) qsa[vt][j] *= egc[j];
#pragma unroll
            for (int ks = 0; ks < 2; ++ks) { const bf16x8 Vf = *(const LAS bf16x8*)(VN + (16 * (4 * vh + vt) + c16) * 72 + 32 * ks + 8 * q);
                qsa[vt] = __builtin_amdgcn_mfma_f32_16x16x32_bf16(QKf[ks], Vf, qsa[vt], 0, 0, 0); }
#pragma unroll
            for (int j = 0; j < 4; ++j) ss[j] += qsa[vt][j] * qsa[vt][j]; }
#pragma unroll
        for (int j = 0; j < 4; ++j) { ss[j] += __shfl_xor(ss[j], 1); ss[j] += __shfl_xor(ss[j], 2); ss[j] += __shfl_xor(ss[j], 4); ss[j] += __shfl_xor(ss[j], 8); }
        if (c16 == 0) *(LAS f32x4*)(ssx + w * 16 + 4 * q) = (f32x4){ss[0], ss[1], ss[2], ss[3]};
        LBAR();
        { const f32x4 sa = *(const LAS f32x4*)(ssx + w * 16 + 4 * q), sb = *(const LAS f32x4*)(ssx + (w ^ 1) * 16 + 4 * q);
          bf16_t* ob_ = ON + (size_t)t0 * 2048 + h * 128;
#pragma unroll
          for (int j = 0; j < 4; ++j) { const float rstd = rsqrtf((sa[j] + sb[j]) * (1.0f / 128.0f) + EPS);
#pragma unroll
              for (int vt = 0; vt < 4; ++vt) ob_[offV + (unsigned)(j * 2048 + vt * 16)] = (bf16_t)(pk2(qsa[vt][j] * rstd * on_g[vt] * silu_f(bf2f(zzr[vt][j >> 1][j & 1])), 0.f) & 0xffffu); } }
        bf16x8 KTf[2][2];
#pragma unroll
        for (int kk = 0; kk < 2; ++kk)
#pragma unroll
            for (int ks = 0; ks < 2; ++ks) KTf[kk][ks] = *(const LAS bf16x8*)(KT + (16 * (2 * ct + kk) + c16) * 72 + 32 * ks + 8 * q);
#pragma unroll
        for (int vtl = 0; vtl < 4; ++vtl) { const int vt = 4 * vh + vtl; bf16x8 Vf[2];
#pragma unroll
            for (int ks = 0; ks < 2; ++ks) Vf[ks] = *(const LAS bf16x8*)(VS + (16 * vt + c16) * 72 + 32 * ks + 8 * q);
#pragma unroll
            for (int kk = 0; kk < 2; ++kk) { const int x = kk * 4 + vtl; S[x] = S[x] * egl;
#pragma unroll
                for (int ks = 0; ks < 2; ++ks) S[x] = __builtin_amdgcn_mfma_f32_16x16x32_bf16(KTf[kk][ks], Vf[ks], S[x], 0, 0, 0);
                u32x2 pk; pk.x = pk2(S[x][0], S[x][1]); pk.y = pk2(S[x][2], S[x][3]);
                *(LAS u32x2*)(ST + (16 * vt + c16) * 136 + 16 * (2 * ct + kk) + 4 * q) = pk; } }
    }
#pragma unroll
    for (int kk = 0; kk < 2; ++kk)
#pragma unroll
        for (int vtl = 0; vtl < 4; ++vtl)
#pragma unroll
            for (int j = 0; j < 4; ++j) s_out[(size_t)(16 * (2 * ct + kk) + 4 * q + j) * 128 + 16 * (4 * vh + vtl) + c16] = S[kk * 4 + vtl][j];
    LBAR();
}
__device__ __forceinline__ void gdn_sample_item(Frame& F, int p) {
    LAS bf16_t* KT = (LAS bf16_t*)F.lds;
    LAS bf16_t* ST = KT + 128 * 72;
    LAS bf16_t* RT = ST + 128 * 136;
    LAS bf16_t* VS = RT + 128 * 72 * 2;
    LAS float* ssx = (LAS float*)(VS + 128 * 72);
    const bf16_t* QB = WSP(bf16_t, OFF_QB); const bf16_t* KB = WSP(bf16_t, OFF_KB); const bf16_t* VB = WSP(bf16_t, OFF_VB); const bf16_t* Z = WSP(bf16_t, OFF_Z);
    const bf16_t* TQ = WSP(bf16_t, OFF_BIG); const float* GC = WSP(float, OFF_GC); const float* BETA = WSP(float, OFF_BETA);
    bf16_t* ON = WSP(bf16_t, OFF_ON);
    int lane = F.lane; asm volatile("" : "+v"(lane));
    const int w = F.wave, c16 = lane & 15, q = lane >> 4;
    const int s_ = p >> 4, h = p & 15, kh = h >> 1, t0 = TP + s_ * 8; const size_t item = 4096 + (size_t)p;
    const float* s_in = F.in[4] + (size_t)p * 16384; float* s_out = F.out + O_RECS + (size_t)p * 16384;
    f32x4 S[8];
#pragma unroll
    for (int vt = 0; vt < 8; ++vt)
#pragma unroll
        for (int j = 0; j < 4; ++j) S[vt][j] = __builtin_nontemporal_load(s_in + (size_t)(16 * w + 4 * q + j) * 128 + 16 * vt + c16);
    const bool rvalid = c16 < 8; const int rowc = rvalid ? c16 : 0;
    bf16x8 Kf[4], Qf[4], Tf, QKf;
    { const bf16_t* kp = KB + (size_t)(t0 + rowc) * 1024 + kh * 128 + 8 * q; const bf16_t* qp = QB + (size_t)(t0 + rowc) * 1024 + kh * 128 + 8 * q;
#pragma unroll
      for (int ks = 0; ks < 4; ++ks) { Kf[ks] = *(const bf16x8*)(kp + 32 * ks); Qf[ks] = *(const bf16x8*)(qp + 32 * ks); }
      if (!rvalid) {
#pragma unroll
          for (int ks = 0; ks < 4; ++ks) { Kf[ks] = (bf16x8){0, 0, 0, 0, 0, 0, 0, 0}; Qf[ks] = (bf16x8){0, 0, 0, 0, 0, 0, 0, 0}; } }
      const bf16_t* tp = TQ + item * 8192 + c16 * 64 + 8 * q; Tf = *(const bf16x8*)tp; QKf = *(const bf16x8*)(tp + 4096); }
    const int i0 = 4 * q;
    const f32x4 gc4 = *(const f32x4*)(GC + item * 64 + i0), beta4 = *(const f32x4*)(BETA + item * 64 + i0);
    const float gcl = GC[item * 64 + 63];
    float vv[4], zz[4];
#pragma unroll
    for (int j = 0; j < 4; ++j) { const bool ok = (i0 + j) < 8; const size_t o = (size_t)(t0 + (ok ? i0 + j : 0)) * 2048 + h * 128 + 16 * w + c16;
        const float v_ = bf2f(VB[o]), z_ = bf2f(Z[o]); vv[j] = ok ? v_ : 0.f; zz[j] = ok ? z_ : 0.f; }
    const float on_g = F.in[15][16 * w + c16];
    if (lane < 32) { u32x4 k0 = {0u, 0u, 0u, 0u}, k1 = {0u, 0u, 0u, 0u};
        { const u32x4* kp = (const u32x4*)(KB + (size_t)(t0 + (lane < 8 ? lane : 0)) * 1024 + kh * 128 + 16 * w); k0 = kp[0]; k1 = kp[1]; if (lane >= 8) { k0 = (u32x4){0u, 0u, 0u, 0u}; k1 = (u32x4){0u, 0u, 0u, 0u}; } }
        LAS bf16_t* kt = KT + (16 * w) * 72 + lane;
        kt[0 * 72] = (bf16_t)(k0.x & 0xffff); kt[1 * 72] = (bf16_t)(k0.x >> 16); kt[2 * 72] = (bf16_t)(k0.y & 0xffff); kt[3 * 72] = (bf16_t)(k0.y >> 16);
        kt[4 * 72] = (bf16_t)(k0.z & 0xffff); kt[5 * 72] = (bf16_t)(k0.z >> 16); kt[6 * 72] = (bf16_t)(k0.w & 0xffff); kt[7 * 72] = (bf16_t)(k0.w >> 16);
        kt[8 * 72] = (bf16_t)(k1.x & 0xffff); kt[9 * 72] = (bf16_t)(k1.x >> 16); kt[10 * 72] = (bf16_t)(k1.y & 0xffff); kt[11 * 72] = (bf16_t)(k1.y >> 16);
        kt[12 * 72] = (bf16_t)(k1.z & 0xffff); kt[13 * 72] = (bf16_t)(k1.z >> 16); kt[14 * 72] = (bf16_t)(k1.w & 0xffff); kt[15 * 72] = (bf16_t)(k1.w >> 16); }
#pragma unroll
    for (int vt = 0; vt < 8; ++vt) { u32x2 pk; pk.x = pk2(S[vt][0], S[vt][1]); pk.y = pk2(S[vt][2], S[vt][3]);
        *(LAS u32x2*)(ST + (16 * vt + c16) * 136 + 16 * w + 4 * q) = pk; }
    float egc[4], edl[4];
#pragma unroll
    for (int j = 0; j < 4; ++j) { egc[j] = __expf(gc4[j]); edl[j] = __expf(gcl - gc4[j]); }
    const float egl = __expf(gcl);
    LBAR();
    f32x4 ksa = {0.f, 0.f, 0.f, 0.f}, qsa = {0.f, 0.f, 0.f, 0.f};
#pragma unroll
    for (int ks = 0; ks < 4; ++ks) { const bf16x8 Sf = *(const LAS bf16x8*)(ST + (16 * w + c16) * 136 + 32 * ks + 8 * q);
        ksa = __builtin_amdgcn_mfma_f32_16x16x32_bf16(Kf[ks], Sf, ksa, 0, 0, 0); qsa = __builtin_amdgcn_mfma_f32_16x16x32_bf16(Qf[ks], Sf, qsa, 0, 0, 0); }
    { float r[4];
#pragma unroll
      for (int j = 0; j < 4; ++j) r[j] = beta4[j] * (vv[j] - egc[j] * ksa[j]);
      u32x2 pk; pk.x = pk2(r[0], r[1]); pk.y = pk2(r[2], r[3]);
      if (q < 2) *(LAS u32x2*)(RT + (16 * w + c16) * 72 + i0) = pk;
      else *(LAS u32x2*)(RT + (16 * w + c16) * 72 + i0) = (u32x2){0u, 0u};
      *(LAS u32x2*)(RT + (16 * w + c16) * 72 + 16 + i0) = (u32x2){0u, 0u}; }
    LDS_WAIT();
    f32x4 vn = {0.f, 0.f, 0.f, 0.f};
    { const bf16x8 Rf = *(const LAS bf16x8*)(RT + (16 * w + c16) * 72 + 8 * q);
      vn = __builtin_amdgcn_mfma_f32_16x16x32_bf16(Tf, Rf, vn, 0, 0, 0); }
    { u32x2 pa, pb; pa.x = pk2(vn[0], vn[1]); pa.y = pk2(vn[2], vn[3]);
      pb.x = pk2(vn[0] * edl[0], vn[1] * edl[1]); pb.y = pk2(vn[2] * edl[2], vn[3] * edl[3]);
      if (q >= 2) { pa = (u32x2){0u, 0u}; pb = (u32x2){0u, 0u}; }
      LAS bf16_t* vnr = RT + 128 * 72 + (16 * w + c16) * 72;
      *(LAS u32x2*)(vnr + i0) = pa; *(LAS u32x2*)(vnr + 16 + i0) = (u32x2){0u, 0u};
      *(LAS u32x2*)(VS + (16 * w + c16) * 72 + i0) = pb; *(LAS u32x2*)(VS + (16 * w + c16) * 72 + 16 + i0) = (u32x2){0u, 0u}; }
    LDS_WAIT();
#pragma unroll
    for (int j = 0; j < 4; ++j) qsa[j] *= egc[j];
    { const bf16x8 Vf = *(const LAS bf16x8*)(RT + 128 * 72 + (16 * w + c16) * 72 + 8 * q);
      qsa = __builtin_amdgcn_mfma_f32_16x16x32_bf16(QKf, Vf, qsa, 0, 0, 0); }
    float ss[4];
#pragma unroll
    for (int j = 0; j < 4; ++j) { ss[j] = qsa[j] * qsa[j]; ss[j] += __shfl_xor(ss[j], 1); ss[j] += __shfl_xor(ss[j], 2); ss[j] += __shfl_xor(ss[j], 4); ss[j] += __shfl_xor(ss[j], 8); }
    if (c16 == 0) *(LAS f32x4*)(ssx + w * 16 + 4 * q) = (f32x4){ss[0], ss[1], ss[2], ss[3]};
    LBAR();
    if (q < 2) {
        f32x4 tot = {0.f, 0.f, 0.f, 0.f};
#pragma unroll
        for (int ww = 0; ww < 8; ++ww) tot = tot + *(const LAS f32x4*)(ssx + ww * 16 + 4 * q);
#pragma unroll
        for (int j = 0; j < 4; ++j) { const float rstd = rsqrtf(tot[j] * (1.0f / 128.0f) + EPS);
            ON[(size_t)(t0 + i0 + j) * 2048 + h * 128 + 16 * w + c16] = (bf16_t)(pk2(qsa[j] * rstd * on_g * silu_f(zz[j]), 0.f) & 0xffffu); }
    }
    const bf16x8 KTf = *(const LAS bf16x8*)(KT + (16 * w + c16) * 72 + 8 * q);
#pragma unroll
    for (int vt = 0; vt < 8; ++vt) { S[vt] = S[vt] * egl;
        const bf16x8 Vf = *(const LAS bf16x8*)(VS + (16 * vt + c16) * 72 + 8 * q);
        S[vt] = __builtin_amdgcn_mfma_f32_16x16x32_bf16(KTf, Vf, S[vt], 0, 0, 0); }
#pragma unroll
    for (int vt = 0; vt < 8; ++vt)
#pragma unroll
        for (int j = 0; j < 4; ++j) __builtin_nontemporal_store(S[vt][j], s_out + (size_t)(16 * w + 4 * q + j) * 128 + 16 * vt + c16);
}
__device__ __forceinline__ void gdn_scan_phase(Frame& F, bool only_prompt) {
    for (int p = F.blk; p < 128; p += F.G) { const int b = p >> 4, h = p & 15;
        gdn_scan_item(F, b * SEQ, 32, 64, b * 512 + h, 16, h, nullptr, F.out + O_RECP + (size_t)p * 16384); }
    const int sblk = (F.G >= 256) ? F.blk - 128 : F.blk, sG = (F.G >= 256) ? F.G - 128 : F.G;
    if (sblk >= 0 && !only_prompt)
        for (int p = sblk; p < 2048; p += sG) gdn_sample_item(F, p);
    if (sblk >= 0 && !only_prompt) { LBAR(); transpose_items(F, true, sblk * 8 + F.wave, sG * 8); }
}

__device__ __forceinline__ void run_gemm_ffn_in(Frame& F, int ly) {
    pg8::Gemm<1024, 1024, 0> g{WSP(bf16_t, OFF_H), WSP(bf16_t, OFF_WFI) + (size_t)ly * NFI * 1024};
    pg8::StaticOrder<T / 256, NFI / 256, 16, 0, 0> S; S.init(F.G, F.blk);
    pg8::EpiSwiGLU E{WSP(bf16_t, OFF_BIG)};
    pg8::gemm_phase(F.lds, g, S, E, F.tid);
}
__device__ __forceinline__ void run_gemm_ffn_out(Frame& F, int ly) {
    pg8::Gemm<DFF, DFF, 0> g{WSP(bf16_t, OFF_BIG), WSP(bf16_t, OFF_WFO) + (size_t)ly * 1024 * DFF};
    pg8::StaticOrder<64, 4, 44, 4, 11> S; S.init(F.G, F.blk);
    pg8::EpiF32Scale E{WSP(float, OFF_MR), 1024, WSP(float, OFF_Z), TP};
    pg8::gemm_phase(F.lds, g, S, E, F.tid);
}

__global__ void __launch_bounds__(512, 2) fwd_megakernel(Args a) {
    extern __shared__ __attribute__((aligned(16))) unsigned char lds_raw[];
    cg::grid_group grid = cg::this_grid();
    Frame F;
    F.lds = (LAS unsigned char*)lds_raw;
    volatile LAS unsigned* xb_st = (volatile LAS unsigned*)(F.lds + (LDS_BYTES - 16));
    unsigned* xb_bar = (unsigned*)(a.ws + OFF_BAR);
    if (threadIdx.x == 0) { xb_st[0] = 0u; xb_st[1] = 0u; (void)xb_add(&xb_bar[XB_XCNT(xb_xcc_id())], 1u); }
    __syncthreads();
    if (a.ph_lo < 0) grid.sync();
#pragma unroll
    for (int i = 0; i < 19; ++i) F.in[i] = a.in[i];
    F.out = a.out; F.ws = a.ws;
#ifndef DUP_MASK
#define DUP_MASK 0
#endif
    for (int ph2 = 2 * a.ph_lo; ph2 < 2 * a.ph_hi; ++ph2) {
        const int ph = ph2 >> 1;
        if ((ph2 & 1) && !((DUP_MASK >> ph) & 1)) continue;
        { int t_ = threadIdx.x; asm volatile("" : "+v"(t_));
          int b_ = blockIdx.x, g_ = gridDim.x; asm volatile("" : "+s"(b_), "+s"(g_));
          F.blk = b_; F.G = g_; F.NGW = g_ * 8;
          F.tid = t_; F.lane = t_ & 63; F.wave = __builtin_amdgcn_readfirstlane(t_ >> 6); F.gw = F.blk * 8 + F.wave; }
        switch (ph) {
        case 0: if (PHON(0)) prep_phase(F); break;
        case 1: if (PHON(1)) { pg8::Gemm<1024, 256, 256> g{WSP(bf16_t, OFF_DB), WSP(bf16_t, OFF_WP)};
                  pg8::StaticOrder<T / 256, 4, 4, 0, 0> S; S.init(F.G, F.blk);
                  pg8::EpiF32Scale E{WSP(float, OFF_MR), 1024, nullptr, 0};
                  pg8::gemm_phase(F.lds, g, S, E, F.tid); } break;
        case 2: if (PHON(2)) row_phase<0>(F, F.in[0], F.in[1], F.in[6], F.in[7], F.in[10], false); break;
        case 3: if (PHON(3)) run_gemm_ffn_in(F, 0); break;
        case 4: if (PHON(4)) run_gemm_ffn_out(F, 0); break;
        case 5: if (PHON(5)) row_phase<11>(F, nullptr, nullptr, F.in[8], F.in[5] + D, nullptr, false); break;
        case 6: if (PHON(6)) { pg8::Gemm<1024, 1024, 0> g{WSP(bf16_t, OFF_H), WSP(bf16_t, OFF_WGI)};
                  pg8::StaticOrder<T / 256, NGIP / 256, 16, 0, 0> S; S.init(F.G, F.blk);
                  pg8::EpiProj E{WSP(bf16_t, OFF_BIG), WSP(bf16_t, OFF_Z), WSP(bf16_t, OFF_BA)};
                  pg8::gemm_phase(F.lds, g, S, E, F.tid); } break;
        case 7: if (PHON(7)) conv_phase(F); break;
        case 8: if (PHON(8)) gdn_pre_phase(F); break;
        case 9: if (PHON(9)) gdn_scan_phase(F, false); break;
        case 10: if (PHON(10)) { pg8::Gemm<2048, 2048, 0> g{WSP(bf16_t, OFF_ON), WSP(bf16_t, OFF_WGO)};
                   pg8::StaticOrder<64, 4, 32, 4, 8> S; S.init(F.G, F.blk);
                   pg8::EpiF32Scale E{WSP(float, OFF_MR), 1024, WSP(float, OFF_Z), TP};
                   pg8::gemm_phase(F.lds, g, S, E, F.tid); } break;
        case 11: if (PHON(11)) row_phase<8>(F, nullptr, nullptr, F.in[6] + D, F.in[7] + D, nullptr, false); break;
        case 12: if (PHON(12)) run_gemm_ffn_in(F, 1); break;
        case 13: if (PHON(13)) run_gemm_ffn_out(F, 1); break;
        case 14: if (PHON(14)) row_phase<11>(F, nullptr, nullptr, F.in[8] + D, nullptr, nullptr, true); break;
        default: break;
        }
        if (ph2 + 1 < 2 * a.ph_hi) xcd_barrier(xb_bar, xb_st);
    }
}

extern "C" void kernel_launch(void* const* d_in, const int* in_sizes, int n_in, void* d_out, int out_size, void* d_ws, size_t ws_size, hipStream_t stream) {
    static int grid = 0;
    if (grid == 0) {
        if (n_in != 19 || ws_size < WS_END) { fprintf(stderr, "kernel_launch: unexpected n_in %d / ws %zu (need %zu)\n", n_in, ws_size, (size_t)WS_END); grid = -1; return; }
        int dev = 0, cus = 0, per_cu = 0;
        (void)hipGetDevice(&dev); (void)hipDeviceGetAttribute(&cus, hipDeviceAttributeMultiprocessorCount, dev);
        if (hipFuncSetAttribute((const void*)fwd_megakernel, hipFuncAttributeMaxDynamicSharedMemorySize, LDS_BYTES) != hipSuccess) { fprintf(stderr, "kernel_launch: hipFuncSetAttribute failed\n"); grid = -1; return; }
        if (hipOccupancyMaxActiveBlocksPerMultiprocessor(&per_cu, (const void*)fwd_megakernel, 512, LDS_BYTES) != hipSuccess || per_cu < 1) { fprintf(stderr, "kernel_launch: occupancy query says %d\n", per_cu); per_cu = 1; }
        (void)hipGetLastError();
        grid = cus;
    }
    if (grid < 0) return;
    Args a{};
    for (int i = 0; i < 19; ++i) a.in[i] = (const float*)d_in[i];
    a.out = (float*)d_out; a.ws = (unsigned char*)d_ws;
#ifndef PER_PHASE_LAUNCH
#define PER_PHASE_LAUNCH 0
#endif
    const int step = PER_PHASE_LAUNCH ? 1 : NPHASE;
    if (hipMemsetAsync((unsigned char*)d_ws + OFF_BAR, 0, 16384, stream) != hipSuccess) { fprintf(stderr, "kernel_launch: memset of barrier words failed\n"); return; }
#ifndef PH_END
#define PH_END NPHASE
#endif
    for (int p0 = 0; p0 < PH_END; p0 += step) {
        a.ph_lo = p0; a.ph_hi = (p0 + step < PH_END) ? p0 + step : PH_END;
        void* args[] = {&a};
        hipError_t e = hipLaunchCooperativeKernel((const void*)fwd_megakernel, dim3(grid), dim3(512), args, LDS_BYTES, stream);
        if (e != hipSuccess) { fprintf(stderr, "cooperative launch failed: %s (grid %d)\n", hipGetErrorString(e), grid); break; }
    }
}
```
